# Optimizing an MI355X kernel written in HIP

```python
import jax, jax.numpy as jnp
from jax import lax
import numpy as np

D_MODEL = 2048
BATCH = 1
SEQ = 16384
DEPTH = 1

CHUNK = 64

D_LRU = D_MODEL
LRU_BLOCKS = 16
LRU_BLOCK_W = D_LRU // LRU_BLOCKS
CONV_W = 4
LRU_C = 8.0

SB_HEADS = 16
SB_HEAD_DIM = 128
D_SB = SB_HEADS * SB_HEAD_DIM
Q_BLOCK = 128

D_CAT = D_LRU + D_SB
N_IN = 2 * D_LRU + 4 * D_SB + D_CAT
EPS = 1e-6

kernel_name = "hybrid_rglru_stickbreaking_gated_merge"


def rmsnorm(x, g):
    xf = x.astype(jnp.float32)
    y = xf * lax.rsqrt(jnp.mean(xf * xf, axis=-1, keepdims=True) + EPS)
    return (y * g.astype(jnp.float32)).astype(x.dtype)


def causal_depthwise_conv(x, w, b):
    K = w.shape[0]
    S = x.shape[1]
    xp = jnp.pad(x, ((0, 0), (K - 1, 0), (0, 0)))
    y = b
    for tap in range(K):
        y = y + xp[:, tap:tap + S] * w[tap]
    return y


def rg_lru(xc, w_rg, b_rg, w_ig, b_ig, lam):
    B, S, C = xc.shape
    xf = xc.astype(jnp.float32)
    xb = xf.reshape(B, S, LRU_BLOCKS, LRU_BLOCK_W)
    r = jax.nn.sigmoid(jnp.einsum('bshi,hij->bshj', xb, w_rg.astype(jnp.float32)).reshape(B, S, C) + b_rg.astype(jnp.float32))
    i = jax.nn.sigmoid(jnp.einsum('bshi,hij->bshj', xb, w_ig.astype(jnp.float32)).reshape(B, S, C) + b_ig.astype(jnp.float32))
    log_a = LRU_C * r * jax.nn.log_sigmoid(lam.astype(jnp.float32))
    a = jnp.exp(log_a)
    u = jnp.sqrt(-jnp.expm1(2.0 * log_a)) * (i * xf)

    def combine(c1, c2):
        a1, b1 = c1
        a2, b2 = c2
        return a1 * a2, a2 * b1 + b2

    _, h = lax.associative_scan(combine, (a, u), axis=1)
    return h.astype(xc.dtype)


def stick_breaking_attention(q, k, v):
    S = q.shape[2]
    scale = SB_HEAD_DIM ** -0.5
    outs = []
    for blk in range(S // Q_BLOCK):
        q0 = blk * Q_BLOCK
        end = q0 + Q_BLOCK
        qb = q[:, :, q0:end].astype(jnp.float32)
        kb = k[:, :, :end].astype(jnp.float32)
        vb = v[:, :, :end].astype(jnp.float32)
        z = jnp.einsum('bhqd,bhkd->bhqk', qb, kb) * scale
        t_q = q0 + jnp.arange(Q_BLOCK)[:, None]
        t_k = jnp.arange(end)[None, :]
        mask = t_k < t_q
        log_rem = jnp.where(mask, jax.nn.log_sigmoid(-z), 0.0)
        between = lax.cumsum(log_rem, axis=3, reverse=True) - log_rem
        w = jnp.where(mask, jnp.exp(jax.nn.log_sigmoid(z) + between), 0.0)
        outs.append(jnp.einsum('bhqk,bhkd->bhqd', w, vb))
    return jnp.concatenate(outs, axis=2).astype(q.dtype)


def setup_inputs(seed: int = 0) -> dict:
    key = jax.random.key(seed)
    ks = jax.random.split(key, 13)
    f32 = jnp.float32
    x = jax.random.normal(ks[0], (BATCH, SEQ, D_MODEL), f32)
    norm_g = 1.0 + 0.01 * jax.random.normal(ks[1], (DEPTH, D_MODEL), f32)
    w_in = jax.random.normal(ks[2], (DEPTH, D_MODEL, N_IN), f32) * D_MODEL ** -0.5
    conv_w = jax.random.normal(ks[3], (DEPTH, CONV_W, D_LRU), f32) * CONV_W ** -0.5
    conv_b = 0.01 * jax.random.normal(ks[4], (DEPTH, D_LRU), f32)
    w_rg = jax.random.normal(ks[5], (DEPTH, LRU_BLOCKS, LRU_BLOCK_W, LRU_BLOCK_W), f32) * LRU_BLOCK_W ** -0.5
    b_rg = 0.01 * jax.random.normal(ks[6], (DEPTH, D_LRU), f32)
    w_ig = jax.random.normal(ks[7], (DEPTH, LRU_BLOCKS, LRU_BLOCK_W, LRU_BLOCK_W), f32) * LRU_BLOCK_W ** -0.5
    b_ig = 0.01 * jax.random.normal(ks[8], (DEPTH, D_LRU), f32)
    u = jax.random.uniform(ks[9], (DEPTH, D_LRU), f32, minval=0.9, maxval=0.999)
    p = u ** (1.0 / LRU_C)
    lru_lambda = jnp.log(p) - jnp.log1p(-p)
    b_merge = 0.01 * jax.random.normal(ks[10], (DEPTH, D_CAT), f32)
    w_out = jax.random.normal(ks[11], (DEPTH, D_CAT, D_MODEL), f32) * D_CAT ** -0.5
    final_g = 1.0 + 0.01 * jax.random.normal(ks[12], (D_MODEL,), f32)
    return {"x": x, "norm_g": norm_g, "w_in": w_in, "conv_w": conv_w, "conv_b": conv_b,
            "w_rg": w_rg, "b_rg": b_rg, "w_ig": w_ig, "b_ig": b_ig, "lru_lambda": lru_lambda,
            "b_merge": b_merge, "w_out": w_out, "final_g": final_g}


def reference(x, norm_g, w_in, conv_w, conv_b, w_rg, b_rg, w_ig, b_ig, lru_lambda, b_merge, w_out, final_g):
    B, S, _ = x.shape
    for l in range(DEPTH):
        h = rmsnorm(x, norm_g[l])
        proj = jnp.einsum('bsd,dn->bsn', h, w_in[l])
        offs = np.cumsum([0, D_LRU, D_LRU, D_SB, D_SB, D_SB, D_SB, D_CAT])
        lru_x, lru_gate, q, k, v, sb_gate, merge_logits = [proj[..., offs[j]:offs[j + 1]] for j in range(7)]

        xc = causal_depthwise_conv(lru_x, conv_w[l], conv_b[l])
        y_lru = rg_lru(xc, w_rg[l], b_rg[l], w_ig[l], b_ig[l], lru_lambda[l]) * jax.nn.silu(lru_gate)

        to_heads = lambda t: t.reshape(B, S, SB_HEADS, SB_HEAD_DIM).transpose(0, 2, 1, 3)
        o = stick_breaking_attention(to_heads(q), to_heads(k), to_heads(v))
        y_sb = o.transpose(0, 2, 1, 3).reshape(B, S, D_SB) * jax.nn.silu(sb_gate)

        g = jax.nn.sigmoid(merge_logits + b_merge[l])
        merged = jnp.concatenate([y_lru, y_sb], axis=-1) * g
        x = x + jnp.einsum('bsc,cd->bsd', merged, w_out[l])
    return rmsnorm(x, final_g)
```

```cpp
#include <hip/hip_runtime.h>
#include <hip/hip_cooperative_groups.h>
#include <cstdio>
namespace cg = cooperative_groups;
namespace pg8 {
#define PG8_LAS __attribute__((address_space(3)))
typedef unsigned short bf16_t;
typedef short bf16x8 __attribute__((ext_vector_type(8)));
typedef float f32x4 __attribute__((ext_vector_type(4)));
typedef unsigned u32x4 __attribute__((ext_vector_type(4)));
constexpr int BM = 256, BK = 64, HALF = 128, HTB = HALF * BK * 2  , STAGE_BYTES = 8 * HTB, NXCD = 8, WGM = 8;

__host__ __device__ __forceinline__ int lds_byte(int r, int c) { const int st = (r >> 4) * 2 + (c >> 5), rr = r & 15, cc = c & 31, ob = rr * 64 + cc * 2; return st * 1024 + (ob ^ (((ob >> 9) & 1) << 5)); }
__host__ __device__ __forceinline__ void stage_rc(int b, int& R, int& C) { const int st = b / 1024, sb = b % 1024, swz = sb ^ (((sb >> 9) & 1) << 5); R = (st >> 1) * 16 + swz / 64; C = (st & 1) * 32 + (swz % 64) / 2; }
__host__ __device__ __forceinline__ int perm32(int rho) { const int n = rho >> 4, i = rho & 15; return 8 * (i >> 2) + 4 * n + (i & 3); }

struct Unit { int pm, pn; };
struct Gemm { const bf16_t* A; const bf16_t* Bt; int M, N, K; };

struct StaticOrder {
    int nM, nN, nwg, G, c;
    __host__ __device__ void init(int M, int N, int G_, int c_) { nM = M / BM; nN = N / BM; nwg = nM * nN; G = G_; c = c_; }
    __host__ __device__ bool next(int i, Unit& u) const {
        const long L = (long)i * G + c; if (L >= nwg) return false;
        int wgid = (int)L; { const int q = nwg / NXCD, r = nwg % NXCD, xcd = wgid % NXCD, off = wgid / NXCD; wgid = (xcd < r ? xcd * (q + 1) : r * (q + 1) + (xcd - r) * q) + off; }
        const int nig = WGM * nN, gid = wgid / nig, fm = gid * WGM, gsz = (nM - fm) < WGM ? (nM - fm) : WGM;
        u.pm = fm + ((wgid % nig) % gsz); u.pn = (wgid % nig) / gsz; return true;
    }
    __device__ __forceinline__ void a_ready(const Unit&) const {}
    __device__ __forceinline__ void done(const Unit&) const {}
};
__device__ __forceinline__ unsigned cvt_pk_bf16(float lo, float hi) { unsigned r; asm volatile("v_cvt_pk_bf16_f32 %0, %1, %2" : "=v"(r) : "v"(lo), "v"(hi)); return r; }
template <class Epi, class Sched, bool STAMP = false>
__device__ __forceinline__ void gemm_phase(PG8_LAS unsigned char* lds, const Gemm g, const Sched& S, const Epi& E, unsigned long long* stamps) {
    const int tid = threadIdx.x, wid = __builtin_amdgcn_readfirstlane(tid >> 6), lane = tid & 63, wr = wid >> 2, wc = wid & 3, fr = lane & 15, fq = lane >> 4;
    const int K = g.K, nt = K / BK;
    int ts_lo = 0, ts_hi = 0, nts = 0; const unsigned long long rt_entry = STAMP ? (unsigned long long)wall_clock64() : 0ull;
#define PG8_STAMP() do { if (STAMP && wid == 0 && nts < 64) { const unsigned long long _c = (unsigned long long)clock64(); \
        ts_lo = (lane == nts) ? (int)(unsigned)_c : ts_lo; ts_hi = (lane == nts) ? (int)(unsigned)(_c >> 32) : ts_hi; ++nts; } } while (0)
    PG8_STAMP();
    unsigned voffA[2], voffB[2];
#pragma unroll
    for (int i = 0; i < 2; ++i) { int R, C; stage_rc(tid * 16 + i * 8192, R, C); const int Rb = Epi::PERM ? ((R & ~31) + perm32(R & 31)) : R;
        voffA[i] = (unsigned)(R * K + C) * 2u; voffB[i] = (unsigned)(Rb * K + C) * 2u; }
    const size_t kstep = (size_t)(BK * 2);
    const size_t hstep = (size_t)HALF * K * 2;
    const size_t tstep = 2 * hstep;
    const unsigned ldsw = (unsigned)wid * 1024u;
    const int aoff = lds_byte(wr * 64 + fr, fq * 8), boff = lds_byte(wc * 32 + fr, fq * 8);
#define PG8_SA(b, h) (((b) * 2 + (h)) * HTB)
#define PG8_SB(b, h) ((4 + (b) * 2 + (h)) * HTB)
#define PG8_STAGE(bufoff, gbase, voff) do { _Pragma("unroll") for (int _i = 0; _i < 2; ++_i) \
        __builtin_amdgcn_global_load_lds((const unsigned*)((const char*)(gbase) + (voff)[_i]), (PG8_LAS unsigned*)(lds + (bufoff) + ldsw + _i * 8192), 16, 0, 0); } while (0)
#define PG8_LDA(dst, b, h) do { _Pragma("unroll") for (int m = 0; m < 4; ++m) _Pragma("unroll") for (int k = 0; k < 2; ++k) dst[m][k] = *(const PG8_LAS bf16x8*)(lds + PG8_SA(b, h) + aoff + m * 2048 + k * 1024); } while (0)
#define PG8_LDB(dst, b, h) do { _Pragma("unroll") for (int n = 0; n < 2; ++n) _Pragma("unroll") for (int k = 0; k < 2; ++k) dst[n][k] = *(const PG8_LAS bf16x8*)(lds + PG8_SB(b, h) + boff + n * 2048 + k * 1024); } while (0)
#define PG8_MMA(ai, bj, At, Bt) do { __builtin_amdgcn_s_setprio(1); _Pragma("unroll") for (int m = 0; m < 4; ++m) _Pragma("unroll") for (int n = 0; n < 2; ++n) _Pragma("unroll") for (int k = 0; k < 2; ++k) \
        acc[ai][bj][m][n] = __builtin_amdgcn_mfma_f32_16x16x32_bf16(Bt[n][k], At[m][k], acc[ai][bj][m][n], 0, 0, 0); __builtin_amdgcn_s_setprio(0); } while (0)
#define PG8_WAIT_V(n) asm volatile("s_waitcnt vmcnt(" #n ")" ::: "memory")
#define PG8_WAIT_L(n) asm volatile("s_waitcnt lgkmcnt(" #n ")" ::: "memory")
#define PG8_BAR __builtin_amdgcn_s_barrier()
#define PG8_SCHED __builtin_amdgcn_sched_barrier(0)
    Unit cur, nxt; int ui = 0;
    if (!S.next(0, cur)) return;
    f32x4 acc[2][2][4][2];
#pragma unroll
    for (int a = 0; a < 2; ++a)
#pragma unroll
        for (int b = 0; b < 2; ++b)
#pragma unroll
            for (int m = 0; m < 4; ++m)
#pragma unroll
                for (int n = 0; n < 2; ++n) acc[a][b][m][n] = (f32x4){0.f, 0.f, 0.f, 0.f};
    bf16x8 At[4][2], B0[2][2], B1[2][2];
    const char* cA = (const char*)g.A + (size_t)cur.pm * tstep; const char* cB = (const char*)g.Bt + (size_t)cur.pn * tstep;
    S.a_ready(cur);
    PG8_STAGE(PG8_SB(0, 0), cB, voffB); PG8_STAGE(PG8_SA(0, 0), cA, voffA); PG8_STAGE(PG8_SB(0, 1), cB + hstep, voffB); PG8_STAGE(PG8_SA(0, 1), cA + hstep, voffA);
    if (wr == 1) PG8_BAR;
    PG8_WAIT_V(4); PG8_BAR;
    PG8_STAGE(PG8_SB(1, 0), cB + kstep, voffB); PG8_STAGE(PG8_SA(1, 0), cA + kstep, voffA); PG8_STAGE(PG8_SB(1, 1), cB + hstep + kstep, voffB);
    PG8_WAIT_V(6); PG8_BAR;
    PG8_STAMP();
    for (;;) {
        const bool has_next = S.next(ui + 1, nxt);
        const char* nA = has_next ? (const char*)g.A + (size_t)nxt.pm * tstep : cA; const char* nB = has_next ? (const char*)g.Bt + (size_t)nxt.pn * tstep : cB;
        for (int t = 0; t < nt; t += 2) {
            const bool last = (t == nt - 2);
            const char* a1 = cA + (size_t)(t + 1) * kstep;
            const char* a2 = last ? nA : cA + (size_t)(t + 2) * kstep; const char* b2 = last ? nB : cB + (size_t)(t + 2) * kstep;
            const char* a3 = a2 + kstep; const char* b3 = b2 + kstep;
            if (last && has_next) S.a_ready(nxt);
            PG8_LDB(B0, 0, 0); PG8_SCHED; PG8_LDA(At, 0, 0); PG8_STAGE(PG8_SA(1, 1), a1 + hstep, voffA);
            PG8_WAIT_L(8); PG8_BAR; PG8_WAIT_L(0); PG8_MMA(0, 0, At, B0); PG8_BAR; PG8_SCHED;
            PG8_LDB(B1, 0, 1); PG8_STAGE(PG8_SB(0, 0), b2, voffB);
            PG8_BAR; PG8_WAIT_L(0); PG8_MMA(0, 1, At, B1); PG8_BAR;
            PG8_LDA(At, 0, 1); PG8_STAGE(PG8_SA(0, 0), a2, voffA);
            PG8_BAR; PG8_WAIT_L(0); PG8_MMA(1, 0, At, B0); PG8_BAR; PG8_SCHED;
            PG8_STAGE(PG8_SB(0, 1), b2 + hstep, voffB);
            PG8_WAIT_V(6); PG8_BAR; PG8_MMA(1, 1, At, B1); PG8_BAR;
            PG8_LDB(B0, 1, 0); PG8_SCHED; PG8_LDA(At, 1, 0); PG8_STAGE(PG8_SA(0, 1), a2 + hstep, voffA);
            PG8_WAIT_L(8); PG8_BAR; PG8_WAIT_L(0); PG8_MMA(0, 0, At, B0); PG8_BAR; PG8_SCHED;
            PG8_LDB(B1, 1, 1); PG8_STAGE(PG8_SB(1, 0), b3, voffB);
            PG8_BAR; PG8_WAIT_L(0); PG8_MMA(0, 1, At, B1); PG8_BAR;
            PG8_LDA(At, 1, 1); PG8_STAGE(PG8_SA(1, 0), a3, voffA);
            PG8_BAR; PG8_WAIT_L(0); PG8_MMA(1, 0, At, B0); PG8_BAR; PG8_SCHED;
            PG8_STAGE(PG8_SB(1, 1), b3 + hstep, voffB);
            PG8_WAIT_V(6); PG8_BAR; PG8_MMA(1, 1, At, B1); PG8_BAR;
        }
        PG8_STAMP();
        if constexpr (!Epi::AFTER_DRAIN) { E(acc, cur, wr, wc, fr, fq); S.done(cur); }
        PG8_STAMP();
        if (!has_next) break;
#pragma unroll
        for (int a = 0; a < 2; ++a)
#pragma unroll
            for (int b = 0; b < 2; ++b)
#pragma unroll
                for (int m = 0; m < 4; ++m)
#pragma unroll
                    for (int n = 0; n < 2; ++n) acc[a][b][m][n] = (f32x4){0.f, 0.f, 0.f, 0.f};
        cur = nxt; cA = nA; cB = nB; ++ui;
    }
    PG8_WAIT_V(0);
    if (wr == 0) PG8_BAR;
    PG8_BAR;
    if constexpr (Epi::AFTER_DRAIN) { E.fused(acc, cur, wr, wc, fr, fq, lds, wid, lane); S.done(cur); }
    PG8_STAMP();
    if (STAMP && wid == 0) { stamps[lane] = lane < nts ? (((unsigned long long)(unsigned)ts_hi << 32) | (unsigned)ts_lo) : 0ull;
        if (lane == 62) stamps[62] = rt_entry; if (lane == 63) stamps[63] = (unsigned long long)wall_clock64(); }
#undef PG8_STAMP
#undef PG8_SA
#undef PG8_SB
#undef PG8_STAGE
#undef PG8_LDA
#undef PG8_LDB
#undef PG8_MMA
#undef PG8_WAIT_V
#undef PG8_WAIT_L
#undef PG8_BAR
#undef PG8_SCHED
}
}

typedef unsigned short u16;
typedef short bf16x8 __attribute__((ext_vector_type(8)));
typedef short s16x4 __attribute__((ext_vector_type(4)));
typedef float f32x4 __attribute__((ext_vector_type(4)));
typedef float f32x16 __attribute__((ext_vector_type(16)));
typedef unsigned u32x4 __attribute__((ext_vector_type(4)));
typedef unsigned u32x2 __attribute__((ext_vector_type(2)));

constexpr int S_ = 16384, DM = 2048, NIN = 16384, DCAT = 4096;
constexpr int NTHR = 512;
constexpr int LDS_BYTES = 131072;
constexpr size_t MiB = (size_t)1 << 20;
constexpr size_t WS_LX = 0;
constexpr size_t WS_Q = 64 * MiB;
constexpr size_t WS_K = 128 * MiB;
constexpr size_t WS_V = 192 * MiB;
constexpr size_t WS_G = 256 * MiB;
constexpr size_t WS_WOUT = 384 * MiB;
constexpr size_t WS_WRG = 400 * MiB;
constexpr size_t WS_WIG = 400 * MiB + 512 * 1024;
constexpr size_t WS_AGG = 401 * MiB;
constexpr size_t WS_ROWSS = 402 * MiB;
constexpr size_t WS_END = 404 * MiB;
constexpr float LOG2E = 1.4426950408889634f, LN2 = 0.6931471805599453f;
constexpr float QSCALE = 0.08838834764831845f * 1.4426950408889634f;
constexpr float STOP_L2 = -151.0f;

struct Params {
    const float *x, *norm_g, *w_in, *conv_w, *conv_b, *w_rg, *b_rg, *w_ig, *b_ig, *lam, *b_merge, *w_out, *final_g;
    float* out; unsigned char* ws; int ph_lo, ph_hi;
};

#define DI __device__ __forceinline__
DI float bf2f(u16 b) { return __uint_as_float(((unsigned)b) << 16); }
DI float fexp2(float x) { return __builtin_amdgcn_exp2f(x); }
DI float flog2(float x) { return __builtin_amdgcn_logf(x); }
DI float frcp(float x) { return __builtin_amdgcn_rcpf(x); }
DI float wave_sum(float v) { v += __shfl_xor(v, 32); v += __shfl_xor(v, 16); v += __shfl_xor(v, 8); v += __shfl_xor(v, 4); v += __shfl_xor(v, 2); v += __shfl_xor(v, 1); return v; }
#define MFMA32(a, b, c) __builtin_amdgcn_mfma_f32_32x32x16_bf16((a), (b), (c), 0, 0, 0)
DI int crow(int reg, int h) { return (reg & 3) + 8 * (reg >> 2) + 4 * h; }

DI int mapcol(int n) {
    const int seg = n >> 11, c = n & 2047, pr = (c >> 7) * 256 + (c & 127);
    switch (seg) {
        case 0: return c;
        case 1: return 2048 + pr;
        case 2: return 6144 + c;
        case 3: return 8192 + c;
        case 4: return 10240 + c;
        case 5: return 12288 + pr;
        case 6: return 2048 + pr + 128;
        default: return 12288 + pr + 128;
    }
}
DI void tr_tile(const float* src, size_t sp, u16* dst, size_t dp, float* t) {
    const int tid = threadIdx.x;
#pragma unroll
    for (int ps = 0; ps < 2; ++ps) {
        const int r = ps * 32 + (tid >> 4), c4 = (tid & 15) * 4;
        const f32x4 v = *(const f32x4*)(src + (size_t)r * sp + c4);
        t[r * 65 + c4] = v[0]; t[r * 65 + c4 + 1] = v[1]; t[r * 65 + c4 + 2] = v[2]; t[r * 65 + c4 + 3] = v[3];
    }
    __syncthreads();
    const int c = tid >> 3, r8 = (tid & 7) * 8;
    u32x4 w;
    w[0] = pg8::cvt_pk_bf16(t[(r8 + 0) * 65 + c], t[(r8 + 1) * 65 + c]);
    w[1] = pg8::cvt_pk_bf16(t[(r8 + 2) * 65 + c], t[(r8 + 3) * 65 + c]);
    w[2] = pg8::cvt_pk_bf16(t[(r8 + 4) * 65 + c], t[(r8 + 5) * 65 + c]);
    w[3] = pg8::cvt_pk_bf16(t[(r8 + 6) * 65 + c], t[(r8 + 7) * 65 + c]);
    *(u32x4*)(dst + (size_t)c * dp + r8) = w;
    __syncthreads();
}

DI void p0_prep(const Params& p, unsigned char* smem) {
    const int tid = threadIdx.x, lane = tid & 63, wave = tid >> 6;
    u16* HB = (u16*)p.out;
    u16* WINT = (u16*)((unsigned char*)p.out + 64 * MiB);
    u16* WOUT = (u16*)(p.ws + WS_WOUT);
    u16* WRG = (u16*)(p.ws + WS_WRG);
    u16* WIG = (u16*)(p.ws + WS_WIG);
    for (int row = blockIdx.x * 8 + wave; row < S_; row += gridDim.x * 8) {
        const f32x4* xr = (const f32x4*)(p.x + (size_t)row * DM);
        f32x4 v[8]; float ss = 0.f;
#pragma unroll
        for (int i = 0; i < 8; ++i) { v[i] = xr[i * 64 + lane]; ss += v[i][0] * v[i][0] + v[i][1] * v[i][1] + v[i][2] * v[i][2] + v[i][3] * v[i][3]; }
        ss = wave_sum(ss);
        const float rstd = rsqrtf(ss * (1.0f / DM) + 1e-6f);
#pragma unroll
        for (int i = 0; i < 8; ++i) {
            const f32x4 g = ((const f32x4*)p.norm_g)[i * 64 + lane];
            u32x2 o; o[0] = pg8::cvt_pk_bf16(v[i][0] * rstd * g[0], v[i][1] * rstd * g[1]); o[1] = pg8::cvt_pk_bf16(v[i][2] * rstd * g[2], v[i][3] * rstd * g[3]);
            *(u32x2*)(HB + (size_t)row * DM + (i * 64 + lane) * 4) = o;
        }
    }
    float* t = (float*)smem;
    constexpr int T_WIN = 32 * 256, T_WOUT = 64 * 32, T_G = 64;
    for (int ti = blockIdx.x; ti < T_WIN + T_WOUT + 2 * T_G; ti += gridDim.x) {
        if (ti < T_WIN) {
            const int tk = ti & 31, tn = ti >> 5;
            tr_tile(p.w_in + (size_t)(tk * 64) * NIN + tn * 64, NIN, WINT + (size_t)mapcol(tn * 64) * DM + tk * 64, DM, t);
        } else if (ti < T_WIN + T_WOUT) {
            const int u = ti - T_WIN, tc = u & 63, td = u >> 6;
            tr_tile(p.w_out + (size_t)(tc * 64) * DM + td * 64, DM, WOUT + (size_t)(td * 64) * DCAT + tc * 64, DCAT, t);
        } else {
            int u = ti - T_WIN - T_WOUT; const float* src = p.w_rg; u16* dst = WRG;
            if (u >= T_G) { u -= T_G; src = p.w_ig; dst = WIG; }
            const int b = u >> 2, ti2 = (u >> 1) & 1, tj = u & 1;
            tr_tile(src + (size_t)b * 16384 + (ti2 * 64) * 128 + tj * 64, 128, dst + (size_t)b * 16384 + (tj * 64) * 128 + ti2 * 64, 128, t);
        }
    }
}

struct EpiProj {
    static constexpr bool PERM = true, AFTER_DRAIN = false;
    u16 *LX, *Q, *K, *V, *G; const float* bm;
    DI void operator()(const f32x4 (&acc)[2][2][4][2], const pg8::Unit& u, int wr, int wc, int fr, int fq) const {
        const int pn = u.pn, row0 = u.pm * 256 + wr * 64 + fr, cl = wc * 32 + 8 * fq;
        if ((pn >= 8 && pn < 24) || pn >= 48) {
            const int gbase = (pn >= 48 ? 2048 + (pn - 48) * 128 : (pn - 8) * 128) + cl;
            const f32x4 b0 = *(const f32x4*)(bm + gbase), b1 = *(const f32x4*)(bm + gbase + 4);
#pragma unroll
            for (int ai = 0; ai < 2; ++ai)
#pragma unroll
                for (int m = 0; m < 4; ++m) {
                    const f32x4 g0 = acc[ai][0][m][0], g1 = acc[ai][0][m][1];
                    const f32x4 m0 = acc[ai][1][m][0] + b0, m1 = acc[ai][1][m][1] + b1;
                    float o[8];
#pragma unroll
                    for (int e = 0; e < 4; ++e) {
                        o[e] = g0[e] * frcp((1.0f + fexp2(-g0[e] * LOG2E)) * (1.0f + fexp2(-m0[e] * LOG2E)));
                        o[4 + e] = g1[e] * frcp((1.0f + fexp2(-g1[e] * LOG2E)) * (1.0f + fexp2(-m1[e] * LOG2E)));
                    }
                    u32x4 w; w[0] = pg8::cvt_pk_bf16(o[0], o[1]); w[1] = pg8::cvt_pk_bf16(o[2], o[3]); w[2] = pg8::cvt_pk_bf16(o[4], o[5]); w[3] = pg8::cvt_pk_bf16(o[6], o[7]);
                    *(u32x4*)(G + (size_t)(row0 + ai * 128 + m * 16) * DCAT + gbase) = w;
                }
        } else {
            u16* base; int colt; float sc = 1.0f;
            if (pn < 8) { base = LX; colt = pn * 256; }
            else if (pn < 32) { base = Q; colt = (pn - 24) * 256; sc = QSCALE; }
            else if (pn < 40) { base = K; colt = (pn - 32) * 256; }
            else { base = V; colt = (pn - 40) * 256; }
#pragma unroll
            for (int ai = 0; ai < 2; ++ai)
#pragma unroll
                for (int m = 0; m < 4; ++m)
#pragma unroll
                    for (int bj = 0; bj < 2; ++bj) {
                        const f32x4 v0 = acc[ai][bj][m][0] * sc, v1 = acc[ai][bj][m][1] * sc;
                        u32x4 w; w[0] = pg8::cvt_pk_bf16(v0[0], v0[1]); w[1] = pg8::cvt_pk_bf16(v0[2], v0[3]); w[2] = pg8::cvt_pk_bf16(v1[0], v1[1]); w[3] = pg8::cvt_pk_bf16(v1[2], v1[3]);
                        *(u32x4*)(base + (size_t)(row0 + ai * 128 + m * 16) * DM + colt + bj * 128 + cl) = w;
                    }
        }
    }
};

struct EpiOut {
    static constexpr bool PERM = false, AFTER_DRAIN = false;
    const float* x; float* out; float* rowss;
    DI void operator()(const f32x4 (&acc)[2][2][4][2], const pg8::Unit& u, int wr, int wc, int fr, int fq) const {
        const int row0 = u.pm * 256 + wr * 64 + fr, col0 = u.pn * 256 + wc * 32 + 4 * fq;
#pragma unroll
        for (int ai = 0; ai < 2; ++ai)
#pragma unroll
            for (int m = 0; m < 4; ++m) {
                const int row = row0 + ai * 128 + m * 16; float ss = 0.f;
#pragma unroll
                for (int bj = 0; bj < 2; ++bj)
#pragma unroll
                    for (int n = 0; n < 2; ++n) {
                        const size_t off = (size_t)row * DM + col0 + bj * 128 + n * 16;
                        const f32x4 v = *(const f32x4*)(x + off) + acc[ai][bj][m][n];
                        *(f32x4*)(out + off) = v;
                        ss += v[0] * v[0] + v[1] * v[1] + v[2] * v[2] + v[3] * v[3];
                    }
                ss += __shfl_xor(ss, 16); ss += __shfl_xor(ss, 32);
                if (fq == 0) rowss[(size_t)row * 32 + u.pn * 4 + wc] = ss;
            }
    }
};

constexpr int LRU_XCB = 0, LRU_XCF = 17408, LRU_AB = 17408 + 32768, LRU_PARTS = 17408 + 65536;
template <bool FINAL>
DI void lru_unit(const Params& p, unsigned char* smem, int chunk, int blk) {
    const int tid = threadIdx.x, lane = tid & 63, wave = tid >> 6;
    const u16* LX = (const u16*)(p.ws + WS_LX);
    u16* G = (u16*)(p.ws + WS_G);
    float* AGG = (float*)(p.ws + WS_AGG);
    u16* xcb = (u16*)(smem + LRU_XCB);
    float* xcf = (float*)(smem + LRU_XCF);
    float* abuf = (float*)(smem + LRU_AB);
    float* parts = (float*)(smem + LRU_PARTS);
    const int th = wave >> 2, cq = wave & 3, rr = lane & 31, h = lane >> 5, j = cq * 32 + rr, ch = blk * 128 + j;
    bf16x8 wrg[8], wig[8];
    {
        const u16* WRG = (const u16*)(p.ws + WS_WRG) + (size_t)blk * 16384 + j * 128 + 8 * h;
        const u16* WIG = (const u16*)(p.ws + WS_WIG) + (size_t)blk * 16384 + j * 128 + 8 * h;
#pragma unroll
        for (int ks = 0; ks < 8; ++ks) { wrg[ks] = *(const bf16x8*)(WRG + ks * 16); wig[ks] = *(const bf16x8*)(WIG + ks * 16); }
    }
    const float brg = p.b_rg[ch], big = p.b_ig[ch];
    const float c2 = -8.0f * log1pf(expf(-p.lam[ch])) * LOG2E;
    const int cc = (tid & 63) * 2, tg = tid >> 6, cch = blk * 128 + cc;
    float cw[4][2], cb[2];
#pragma unroll
    for (int tap = 0; tap < 4; ++tap) { cw[tap][0] = p.conv_w[tap * DM + cch]; cw[tap][1] = p.conv_w[tap * DM + cch + 1]; }
    cb[0] = p.conv_b[cch]; cb[1] = p.conv_b[cch + 1];
    const int sc = tid & 127, part = tid >> 7, sch = blk * 128 + sc;
    float h_run = 0.f, a_run = 1.f;
    if (FINAL) {
        for (int n = 0; n < chunk; ++n) h_run = AGG[(size_t)(n * 2) * DM + sch] * h_run + AGG[(size_t)(n * 2 + 1) * DM + sch];
    }
    for (int st = 0; st < 16; ++st) {
        const int t0 = chunk * 1024 + st * 64;
        {
            float xv[11][2];
#pragma unroll
            for (int r = 0; r < 11; ++r) {
                const int tok = t0 + tg * 8 - 3 + r;
                unsigned w = 0u;
                if (tok >= 0) w = *(const unsigned*)(LX + (size_t)tok * DM + cch);
                xv[r][0] = __uint_as_float(w << 16); xv[r][1] = __uint_as_float(w & 0xffff0000u);
            }
#pragma unroll
            for (int q = 0; q < 8; ++q) {
                float y0 = cb[0], y1 = cb[1];
#pragma unroll
                for (int tap = 0; tap < 4; ++tap) { y0 += xv[q + tap][0] * cw[tap][0]; y1 += xv[q + tap][1] * cw[tap][1]; }
                const int tok = tg * 8 + q;
                *(unsigned*)(xcb + tok * 136 + cc) = pg8::cvt_pk_bf16(y0, y1);
                xcf[tok * 128 + cc] = y0; xcf[tok * 128 + cc + 1] = y1;
            }
        }
        __syncthreads();
        {
            f32x16 ar, ai;
#pragma unroll
            for (int i = 0; i < 16; ++i) { ar[i] = 0.f; ai[i] = 0.f; }
#pragma unroll
            for (int ks = 0; ks < 8; ++ks) {
                const bf16x8 a = *(const bf16x8*)(xcb + (th * 32 + rr) * 136 + ks * 16 + 8 * h);
                ar = MFMA32(a, wrg[ks], ar); ai = MFMA32(a, wig[ks], ai);
            }
#pragma unroll
            for (int i = 0; i < 16; ++i) {
                const int tok = th * 32 + crow(i, h);
                const float xv = xcf[tok * 128 + j];
                const float r = frcp(1.0f + fexp2(-(ar[i] + brg) * LOG2E));
                const float ig = frcp(1.0f + fexp2(-(ai[i] + big) * LOG2E));
                const float la2 = r * c2;
                const float a = fexp2(la2);
                const float x2 = la2 * (2.0f * LN2);
                const float poly = -x2 * (1.0f + x2 * (0.5f + x2 * (0.16666667f + x2 * (0.041666668f + x2 * (0.0083333338f + x2 * 0.0013888889f)))));
                const float om = (x2 > -0.25f) ? poly : (1.0f - a * a);
                abuf[tok * 128 + j] = a;
                xcf[tok * 128 + j] = sqrtf(om) * (ig * xv);
            }
        }
        __syncthreads();
        {
            float A = 1.f, B = 0.f;
#pragma unroll
            for (int tt = 0; tt < 16; ++tt) { const float a = abuf[(part * 16 + tt) * 128 + sc], u = xcf[(part * 16 + tt) * 128 + sc]; B = a * B + u; A *= a; }
            parts[part * 128 + sc] = A; parts[512 + part * 128 + sc] = B;
        }
        __syncthreads();
        {
            float hin = h_run;
#pragma unroll
            for (int k = 0; k < 4; ++k) {
                const float A = parts[k * 128 + sc], B = parts[512 + k * 128 + sc];
                if (k < part) hin = A * hin + B;
                h_run = A * h_run + B; a_run *= A;
            }
            if (FINAL) {
                float hh = hin;
#pragma unroll
                for (int tt = 0; tt < 16; ++tt) {
                    const int tok = part * 16 + tt;
                    hh = abuf[tok * 128 + sc] * hh + xcf[tok * 128 + sc];
                    u16* gp = G + (size_t)(t0 + tok) * DCAT + sch;
                    const float o = hh * bf2f(*gp);
                    *gp = (u16)(pg8::cvt_pk_bf16(o, o) & 0xffffu);
                }
            }
        }
        __syncthreads();
    }
    if (!FINAL && part == 0) { AGG[(size_t)(chunk * 2) * DM + sch] = a_run; AGG[(size_t)(chunk * 2 + 1) * DM + sch] = h_run; }
}

constexpr int ATT_K = 0, ATT_V = 17408;
DI void tr4(unsigned a0, unsigned a1, unsigned a2, unsigned a3, s16x4& r0, s16x4& r1, s16x4& r2, s16x4& r3) {
    asm volatile("ds_read_b64_tr_b16 %0, %4\n\tds_read_b64_tr_b16 %1, %5\n\tds_read_b64_tr_b16 %2, %6\n\tds_read_b64_tr_b16 %3, %7\n\ts_waitcnt lgkmcnt(0)"
                 : "=&v"(r0), "=&v"(r1), "=&v"(r2), "=&v"(r3) : "v"(a0), "v"(a1), "v"(a2), "v"(a3) : "memory");
}
DI void attn_unit(const Params& p, unsigned char* smem, int hd, int qb) {
    const int tid = threadIdx.x, lane = tid & 63, wave = tid >> 6;
    const u16* Qg = (const u16*)(p.ws + WS_Q);
    const u16* Kg = (const u16*)(p.ws + WS_K);
    const u16* Vg = (const u16*)(p.ws + WS_V);
    u16* G = (u16*)(p.ws + WS_G);
    u16* Kt = (u16*)(smem + ATT_K);
    u16* Vt = (u16*)(smem + ATT_V);
    const unsigned vbase = (unsigned)(size_t)(smem + ATT_V);
    const int rr = lane & 31, h = lane >> 5, qw = qb * 256 + wave * 32, query = qw + rr;
    const int i16 = lane & 15, q4 = i16 >> 2, p4 = i16 & 3, blk = (lane >> 4) & 1;
    bf16x8 qf[8];
    {
        const u16* qp = Qg + (size_t)query * DM + hd * 128 + 8 * h;
#pragma unroll
        for (int ks = 0; ks < 8; ++ks) qf[ks] = *(const bf16x8*)(qp + ks * 16);
    }
    f32x16 o[4];
#pragma unroll
    for (int d = 0; d < 4; ++d)
#pragma unroll
        for (int i = 0; i < 16; ++i) o[d][i] = 0.f;
    float off2 = 0.f; bool done = false;
    const int lk0 = tid >> 4, lp = tid & 15;
    u32x4 kr[2], vr[2];
    const int kt_hi = qb * 4 + 3;
#define ATT_LOAD(kt) do { _Pragma("unroll") for (int i_ = 0; i_ < 2; ++i_) { const size_t g_ = (size_t)((kt) * 64 + lk0 + i_ * 32) * DM + hd * 128 + lp * 8; \
        kr[i_] = *(const u32x4*)(Kg + g_); vr[i_] = *(const u32x4*)(Vg + g_); } } while (0)
    ATT_LOAD(kt_hi);
    for (int kt = kt_hi; kt >= 0; --kt) {
#pragma unroll
        for (int i = 0; i < 2; ++i) { *(u32x4*)(Kt + (lk0 + i * 32) * 136 + lp * 8) = kr[i]; *(u32x4*)(Vt + (lk0 + i * 32) * 136 + lp * 8) = vr[i]; }
        __syncthreads();
        if (kt > 0) ATT_LOAD(kt - 1);
        if (!done) {
#pragma unroll 1
            for (int sub = 1; sub >= 0; --sub) {
                const int kb = kt * 64 + sub * 32;
                if (kb > qw) continue;
                f32x16 z;
#pragma unroll
                for (int i = 0; i < 16; ++i) z[i] = 0.f;
#pragma unroll
                for (int ks = 0; ks < 8; ++ks) {
                    const bf16x8 a = *(const bf16x8*)(Kt + (sub * 32 + rr) * 136 + ks * 16 + 8 * h);
                    z = MFMA32(a, qf[ks], z);
                }
                float lr[16], zl[16];
#pragma unroll
                for (int i = 0; i < 16; ++i) {
                    const bool valid = (kb + crow(i, h)) < query;
                    const float zz = z[i];
                    const float sp = fmaxf(zz, 0.f) + flog2(1.0f + fexp2(-fabsf(zz)));
                    lr[i] = valid ? -sp : 0.f;
                    zl[i] = valid ? zz - sp : -1.0e30f;
                }
                float T[4], To[4], ex[16];
#pragma unroll
                for (int g = 0; g < 4; ++g) {
                    ex[4 * g + 3] = 0.f; ex[4 * g + 2] = lr[4 * g + 3]; ex[4 * g + 1] = ex[4 * g + 2] + lr[4 * g + 2]; ex[4 * g] = ex[4 * g + 1] + lr[4 * g + 1];
                    T[g] = ex[4 * g] + lr[4 * g];
                    To[g] = __shfl_xor(T[g], 32);
                }
                float Sg[4]; float suf = 0.f;
#pragma unroll
                for (int g = 3; g >= 0; --g) { Sg[g] = suf + (h == 0 ? To[g] : 0.f); suf += T[g] + To[g]; }
                float pw[16];
#pragma unroll
                for (int i = 0; i < 16; ++i) pw[i] = fexp2(zl[i] + off2 + Sg[i >> 2] + ex[i]);
                off2 += suf;
                bf16x8 pf[2];
#pragma unroll
                for (int s = 0; s < 2; ++s) {
                    u32x4 w; w[0] = pg8::cvt_pk_bf16(pw[8 * s], pw[8 * s + 1]); w[1] = pg8::cvt_pk_bf16(pw[8 * s + 2], pw[8 * s + 3]);
                    w[2] = pg8::cvt_pk_bf16(pw[8 * s + 4], pw[8 * s + 5]); w[3] = pg8::cvt_pk_bf16(pw[8 * s + 6], pw[8 * s + 7]);
                    pf[s] = __builtin_bit_cast(bf16x8, w);
                }
#pragma unroll
                for (int d = 0; d < 4; ++d) {
                    const unsigned a = vbase + (unsigned)((sub * 32 + 4 * h + q4) * 272 + (d * 32 + 16 * blk) * 2 + 8 * p4);
                    s16x4 l0, h0, l1, h1;
                    tr4(a, a + 8 * 272, a + 16 * 272, a + 24 * 272, l0, h0, l1, h1);
                    const bf16x8 v0 = __builtin_shufflevector(l0, h0, 0, 1, 2, 3, 4, 5, 6, 7), v1 = __builtin_shufflevector(l1, h1, 0, 1, 2, 3, 4, 5, 6, 7);
                    o[d] = MFMA32(v0, pf[0], o[d]); o[d] = MFMA32(v1, pf[1], o[d]);
                }
            }
            done = (__ballot(off2 >= STOP_L2) == 0ull);
        }
        if (!__syncthreads_or(done ? 0 : 1)) break;
    }
#undef ATT_LOAD
#pragma unroll
    for (int d = 0; d < 4; ++d)
#pragma unroll
        for (int g = 0; g < 4; ++g) {
            u16* gp = G + (size_t)query * DCAT + 2048 + hd * 128 + d * 32 + 8 * g + 4 * h;
            const u32x2 gv = *(const u32x2*)gp;
            u32x2 w;
            w[0] = pg8::cvt_pk_bf16(o[d][4 * g] * __uint_as_float(gv[0] << 16), o[d][4 * g + 1] * __uint_as_float(gv[0] & 0xffff0000u));
            w[1] = pg8::cvt_pk_bf16(o[d][4 * g + 2] * __uint_as_float(gv[1] << 16), o[d][4 * g + 3] * __uint_as_float(gv[1] & 0xffff0000u));
            *(u32x2*)gp = w;
        }
    __syncthreads();
}

DI void p5_norm(const Params& p) {
    const int tid = threadIdx.x, lane = tid & 63, wave = tid >> 6;
    const float* rowss = (const float*)(p.ws + WS_ROWSS);
    for (int row = blockIdx.x * 8 + wave; row < S_; row += gridDim.x * 8) {
        float ss = rowss[(size_t)row * 32 + (lane & 31)];
        ss += __shfl_xor(ss, 16); ss += __shfl_xor(ss, 8); ss += __shfl_xor(ss, 4); ss += __shfl_xor(ss, 2); ss += __shfl_xor(ss, 1);
        const float rstd = rsqrtf(ss * (1.0f / DM) + 1e-6f);
        f32x4* orow = (f32x4*)(p.out + (size_t)row * DM);
#pragma unroll
        for (int i = 0; i < 8; ++i) {
            const f32x4 g = ((const f32x4*)p.final_g)[i * 64 + lane];
            f32x4 v = orow[i * 64 + lane];
            v[0] *= rstd * g[0]; v[1] *= rstd * g[1]; v[2] *= rstd * g[2]; v[3] *= rstd * g[3];
            orow[i * 64 + lane] = v;
        }
    }
}

#ifndef N_LAUNCHES
#define N_LAUNCHES 6
#endif
__global__ void __launch_bounds__(NTHR, 2) mega_fwd(Params p) {
    extern __shared__ __attribute__((aligned(16))) unsigned char smem[];
    cg::grid_group grid = cg::this_grid();
#define IN(k) (p.ph_lo <= (k) && (k) < p.ph_hi)
#define SEAM(k) do { if (IN(k) && IN((k) + 1)) grid.sync(); } while (0)
    if (IN(0)) p0_prep(p, smem);
    SEAM(0);
    if (IN(1)) {
        pg8::Gemm g{(const u16*)p.out, (const u16*)((const unsigned char*)p.out + 64 * MiB), S_, NIN, DM};
        pg8::StaticOrder S; S.init(S_, NIN, (int)gridDim.x, (int)blockIdx.x);
        EpiProj E{(u16*)(p.ws + WS_LX), (u16*)(p.ws + WS_Q), (u16*)(p.ws + WS_K), (u16*)(p.ws + WS_V), (u16*)(p.ws + WS_G), p.b_merge};
        pg8::gemm_phase<EpiProj, pg8::StaticOrder, false>((PG8_LAS unsigned char*)smem, g, S, E, nullptr);
    }
    SEAM(1);
    if (IN(2)) {
        for (int u = blockIdx.x; u < 256; u += gridDim.x) lru_unit<false>(p, smem, u >> 4, u & 15);
        for (int it = blockIdx.x; it < 1024; it += gridDim.x) attn_unit(p, smem, it & 15, it >> 4);
    }
    SEAM(2);
    if (IN(3)) {
        for (int u = blockIdx.x; u < 256; u += gridDim.x) lru_unit<true>(p, smem, u >> 4, u & 15);
    }
    SEAM(3);
    if (IN(4)) {
        pg8::Gemm g{(const u16*)(p.ws + WS_G), (const u16*)(p.ws + WS_WOUT), S_, DM, DCAT};
        pg8::StaticOrder S; S.init(S_, DM, (int)gridDim.x, (int)blockIdx.x);
        EpiOut E{p.x, p.out, (float*)(p.ws + WS_ROWSS)};
        pg8::gemm_phase<EpiOut, pg8::StaticOrder, false>((PG8_LAS unsigned char*)smem, g, S, E, nullptr);
    }
    SEAM(4);
    if (IN(5)) p5_norm(p);
#undef IN
#undef SEAM
}

extern "C" void kernel_launch(void* const* d_in, const int* in_sizes, int n_in, void* d_out, int out_size, void* d_ws, size_t ws_size, hipStream_t stream) {
    static int grid = 0;
    if (grid == 0) {
        int dev = 0, cus = 0, per_cu = 0;
        hipGetDevice(&dev);
        hipDeviceGetAttribute(&cus, hipDeviceAttributeMultiprocessorCount, dev);
        if (hipFuncSetAttribute((const void*)mega_fwd, hipFuncAttributeMaxDynamicSharedMemorySize, LDS_BYTES) != hipSuccess) fprintf(stderr, "kernel_launch: hipFuncSetAttribute failed\n");
        if (hipOccupancyMaxActiveBlocksPerMultiprocessor(&per_cu, (const void*)mega_fwd, NTHR, LDS_BYTES) != hipSuccess || per_cu < 1) { fprintf(stderr, "kernel_launch: occupancy query gave %d\n", per_cu); per_cu = 1; }
        (void)hipGetLastError();
        if (per_cu > 1) per_cu = 1;
        grid = cus * per_cu;
        if (ws_size < WS_END) fprintf(stderr, "kernel_launch: workspace too small: %zu < %zu\n", ws_size, (size_t)WS_END);
    }
    Params p{};
    p.x = (const float*)d_in[0]; p.norm_g = (const float*)d_in[1]; p.w_in = (const float*)d_in[2]; p.conv_w = (const float*)d_in[3]; p.conv_b = (const float*)d_in[4];
    p.w_rg = (const float*)d_in[5]; p.b_rg = (const float*)d_in[6]; p.w_ig = (const float*)d_in[7]; p.b_ig = (const float*)d_in[8]; p.lam = (const float*)d_in[9];
    p.b_merge = (const float*)d_in[10]; p.w_out = (const float*)d_in[11]; p.final_g = (const float*)d_in[12];
    p.out = (float*)d_out; p.ws = (unsigned char*)d_ws;
#if N_LAUNCHES == 1
    p.ph_lo = 0; p.ph_hi = 6;
    void* args[] = {&p};
    hipError_t e = hipLaunchCooperativeKernel((const void*)mega_fwd, dim3(grid), dim3(NTHR), args, LDS_BYTES, stream);
    if (e != hipSuccess) fprintf(stderr, "cooperative launch failed: %s (grid %d)\n", hipGetErrorString(e), grid);
#else
    for (int ph = 0; ph < 6; ++ph) {
        p.ph_lo = ph; p.ph_hi = ph + 1;
        hipLaunchKernelGGL(mega_fwd, dim3(grid), dim3(NTHR), LDS_BYTES, stream, p);
    }
#endif
}
```

```cpp
#include <hip/hip_runtime.h>
#include <hip/hip_cooperative_groups.h>
#include <cstdio>
namespace cg = cooperative_groups;
namespace pg8 {
#define PG8_LAS __attribute__((address_space(3)))
typedef unsigned short bf16_t;
typedef short bf16x8 __attribute__((ext_vector_type(8)));
typedef float f32x4 __attribute__((ext_vector_type(4)));
typedef unsigned u32x4 __attribute__((ext_vector_type(4)));
constexpr int BM = 256, BK = 64, HALF = 128, HTB = HALF * BK * 2  , STAGE_BYTES = 8 * HTB, NXCD = 8, WGM = 8;

__host__ __device__ __forceinline__ int lds_byte(int r, int c) { const int st = (r >> 4) * 2 + (c >> 5), rr = r & 15, cc = c & 31, ob = rr * 64 + cc * 2; return st * 1024 + (ob ^ (((ob >> 9) & 1) << 5)); }
__host__ __device__ __forceinline__ void stage_rc(int b, int& R, int& C) { const int st = b / 1024, sb = b % 1024, swz = sb ^ (((sb >> 9) & 1) << 5); R = (st >> 1) * 16 + swz / 64; C = (st & 1) * 32 + (swz % 64) / 2; }
__host__ __device__ __forceinline__ int perm32(int rho) { const int n = rho >> 4, i = rho & 15; return 8 * (i >> 2) + 4 * n + (i & 3); }

struct Unit { int pm, pn; };
struct Gemm { const bf16_t* A; const bf16_t* Bt; int M, N, K; };

struct StaticOrder {
    int nM, nN, nwg, G, c, rep;
    __host__ __device__ void init(int M, int N, int G_, int c_) { nM = M / BM; nN = N / BM; nwg = nM * nN; G = G_; c = c_; rep = 1; }
    __host__ __device__ bool next(int i, Unit& u) const {
        long L = (long)i * G + c; if (L >= (long)nwg * rep) return false; L %= nwg;
        int wgid = (int)L; { const int q = nwg / NXCD, r = nwg % NXCD, xcd = wgid % NXCD, off = wgid / NXCD; wgid = (xcd < r ? xcd * (q + 1) : r * (q + 1) + (xcd - r) * q) + off; }
        const int nig = WGM * nN, gid = wgid / nig, fm = gid * WGM, gsz = (nM - fm) < WGM ? (nM - fm) : WGM;
        u.pm = fm + ((wgid % nig) % gsz); u.pn = (wgid % nig) / gsz; return true;
    }
    __device__ __forceinline__ void a_ready(const Unit&) const {}
    __device__ __forceinline__ void done(const Unit&) const {}
};
__device__ __forceinline__ unsigned cvt_pk_bf16(float lo, float hi) { unsigned r; asm("v_cvt_pk_bf16_f32 %0, %1, %2" : "=v"(r) : "v"(lo), "v"(hi)); return r; }
template <class Epi, class Sched, bool STAMP = false>
__device__ __forceinline__ void gemm_phase(PG8_LAS unsigned char* lds, const Gemm g, const Sched& S, const Epi& E, unsigned long long* stamps) {
    const int tid = threadIdx.x, wid = __builtin_amdgcn_readfirstlane(tid >> 6), lane = tid & 63, wr = wid >> 2, wc = wid & 3, fr = lane & 15, fq = lane >> 4;
    const int K = g.K, nt = K / BK;
    int ts_lo = 0, ts_hi = 0, nts = 0; const unsigned long long rt_entry = STAMP ? (unsigned long long)wall_clock64() : 0ull;
#define PG8_STAMP() do { if (STAMP && wid == 0 && nts < 64) { const unsigned long long _c = (unsigned long long)clock64(); \
        ts_lo = (lane == nts) ? (int)(unsigned)_c : ts_lo; ts_hi = (lane == nts) ? (int)(unsigned)(_c >> 32) : ts_hi; ++nts; } } while (0)
    PG8_STAMP();
    unsigned voffA[2], voffB[2];
#pragma unroll
    for (int i = 0; i < 2; ++i) { int R, C; stage_rc(tid * 16 + i * 8192, R, C); const int Rb = Epi::PERM ? ((R & ~31) + perm32(R & 31)) : R;
        voffA[i] = (unsigned)(R * K + C) * 2u; voffB[i] = (unsigned)(Rb * K + C) * 2u; }
    const size_t kstep = (size_t)(BK * 2);
    const size_t hstep = (size_t)HALF * K * 2;
    const size_t tstep = 2 * hstep;
    const unsigned ldsw = (unsigned)wid * 1024u;
    const int aoff = lds_byte(wr * 64 + fr, fq * 8), boff = lds_byte(wc * 32 + fr, fq * 8);
#define PG8_SA(b, h) (((b) * 2 + (h)) * HTB)
#define PG8_SB(b, h) ((4 + (b) * 2 + (h)) * HTB)
#define PG8_STAGE(bufoff, gbase, voff) do { _Pragma("unroll") for (int _i = 0; _i < 2; ++_i) \
        __builtin_amdgcn_global_load_lds((const unsigned*)((const char*)(gbase) + (voff)[_i]), (PG8_LAS unsigned*)(lds + (bufoff) + ldsw + _i * 8192), 16, 0, 0); } while (0)
#define PG8_LDA(dst, b, h) do { _Pragma("unroll") for (int m = 0; m < 4; ++m) _Pragma("unroll") for (int k = 0; k < 2; ++k) dst[m][k] = *(const PG8_LAS bf16x8*)(lds + PG8_SA(b, h) + aoff + m * 2048 + k * 1024); } while (0)
#define PG8_LDB(dst, b, h) do { _Pragma("unroll") for (int n = 0; n < 2; ++n) _Pragma("unroll") for (int k = 0; k < 2; ++k) dst[n][k] = *(const PG8_LAS bf16x8*)(lds + PG8_SB(b, h) + boff + n * 2048 + k * 1024); } while (0)
#define PG8_MMA(ai, bj, At, Bt) do { __builtin_amdgcn_s_setprio(1); _Pragma("unroll") for (int m = 0; m < 4; ++m) _Pragma("unroll") for (int n = 0; n < 2; ++n) _Pragma("unroll") for (int k = 0; k < 2; ++k) \
        acc[ai][bj][m][n] = __builtin_amdgcn_mfma_f32_16x16x32_bf16(Bt[n][k], At[m][k], acc[ai][bj][m][n], 0, 0, 0); __builtin_amdgcn_s_setprio(0); } while (0)
#define PG8_WAIT_V(n) asm volatile("s_waitcnt vmcnt(" #n ")" ::: "memory")
#define PG8_WAIT_L(n) asm volatile("s_waitcnt lgkmcnt(" #n ")" ::: "memory")
#define PG8_BAR __builtin_amdgcn_s_barrier()
#define PG8_SCHED __builtin_amdgcn_sched_barrier(0)
    Unit cur, nxt; int ui = 0;
    if (!S.next(0, cur)) return;
    f32x4 acc[2][2][4][2];
#pragma unroll
    for (int a = 0; a < 2; ++a)
#pragma unroll
        for (int b = 0; b < 2; ++b)
#pragma unroll
            for (int m = 0; m < 4; ++m)
#pragma unroll
                for (int n = 0; n < 2; ++n) acc[a][b][m][n] = (f32x4){0.f, 0.f, 0.f, 0.f};
    bf16x8 At[4][2], B0[2][2], B1[2][2];
    const char* cA = (const char*)g.A + (size_t)cur.pm * tstep; const char* cB = (const char*)g.Bt + (size_t)cur.pn * tstep;
    S.a_ready(cur);
    PG8_STAGE(PG8_SB(0, 0), cB, voffB); PG8_STAGE(PG8_SA(0, 0), cA, voffA); PG8_STAGE(PG8_SB(0, 1), cB + hstep, voffB); PG8_STAGE(PG8_SA(0, 1), cA + hstep, voffA);
    if (wr == 1) PG8_BAR;
    PG8_WAIT_V(4); PG8_BAR;
    PG8_STAGE(PG8_SB(1, 0), cB + kstep, voffB); PG8_STAGE(PG8_SA(1, 0), cA + kstep, voffA); PG8_STAGE(PG8_SB(1, 1), cB + hstep + kstep, voffB);
    PG8_WAIT_V(6); PG8_BAR;
    PG8_STAMP();
    for (;;) {
        const bool has_next = S.next(ui + 1, nxt);
        const char* nA = has_next ? (const char*)g.A + (size_t)nxt.pm * tstep : cA; const char* nB = has_next ? (const char*)g.Bt + (size_t)nxt.pn * tstep : cB;
        for (int t = 0; t < nt; t += 2) {
            const bool last = (t == nt - 2);
            const char* a1 = cA + (size_t)(t + 1) * kstep;
            const char* a2 = last ? nA : cA + (size_t)(t + 2) * kstep; const char* b2 = last ? nB : cB + (size_t)(t + 2) * kstep;
            const char* a3 = a2 + kstep; const char* b3 = b2 + kstep;
            if (last && has_next) S.a_ready(nxt);
            PG8_LDB(B0, 0, 0); PG8_SCHED; PG8_LDA(At, 0, 0); PG8_STAGE(PG8_SA(1, 1), a1 + hstep, voffA);
            PG8_WAIT_L(8); PG8_BAR; PG8_WAIT_L(0); PG8_MMA(0, 0, At, B0); PG8_BAR; PG8_SCHED;
            PG8_LDB(B1, 0, 1); PG8_STAGE(PG8_SB(0, 0), b2, voffB);
            PG8_BAR; PG8_WAIT_L(0); PG8_MMA(0, 1, At, B1); PG8_BAR;
            PG8_LDA(At, 0, 1); PG8_STAGE(PG8_SA(0, 0), a2, voffA);
            PG8_BAR; PG8_WAIT_L(0); PG8_MMA(1, 0, At, B0); PG8_BAR; PG8_SCHED;
            PG8_STAGE(PG8_SB(0, 1), b2 + hstep, voffB);
            PG8_WAIT_V(6); PG8_BAR; PG8_MMA(1, 1, At, B1); PG8_BAR;
            PG8_LDB(B0, 1, 0); PG8_SCHED; PG8_LDA(At, 1, 0); PG8_STAGE(PG8_SA(0, 1), a2 + hstep, voffA);
            PG8_WAIT_L(8); PG8_BAR; PG8_WAIT_L(0); PG8_MMA(0, 0, At, B0); PG8_BAR; PG8_SCHED;
            PG8_LDB(B1, 1, 1); PG8_STAGE(PG8_SB(1, 0), b3, voffB);
            PG8_BAR; PG8_WAIT_L(0); PG8_MMA(0, 1, At, B1); PG8_BAR;
            PG8_LDA(At, 1, 1); PG8_STAGE(PG8_SA(1, 0), a3, voffA);
            PG8_BAR; PG8_WAIT_L(0); PG8_MMA(1, 0, At, B0); PG8_BAR; PG8_SCHED;
            PG8_STAGE(PG8_SB(1, 1), b3 + hstep, voffB);
            PG8_WAIT_V(6); PG8_BAR; PG8_MMA(1, 1, At, B1); PG8_BAR;
        }
        PG8_STAMP();
        if (!Epi::AFTER_DRAIN || has_next) { E(acc, cur, wr, wc, fr, fq); S.done(cur); }
        PG8_STAMP();
        if (!has_next) break;
#pragma unroll
        for (int a = 0; a < 2; ++a)
#pragma unroll
            for (int b = 0; b < 2; ++b)
#pragma unroll
                for (int m = 0; m < 4; ++m)
#pragma unroll
                    for (int n = 0; n < 2; ++n) acc[a][b][m][n] = (f32x4){0.f, 0.f, 0.f, 0.f};
        cur = nxt; cA = nA; cB = nB; ++ui;
    }
    PG8_WAIT_V(0);
    if (wr == 0) PG8_BAR;
    PG8_BAR;
    if constexpr (Epi::AFTER_DRAIN) { E.fused(acc, cur, wr, wc, fr, fq, lds, wid, lane); S.done(cur); }
    PG8_STAMP();
    if (STAMP && wid == 0) { stamps[lane] = lane < nts ? (((unsigned long long)(unsigned)ts_hi << 32) | (unsigned)ts_lo) : 0ull;
        if (lane == 62) stamps[62] = rt_entry; if (lane == 63) stamps[63] = (unsigned long long)wall_clock64(); }
#undef PG8_STAMP
#undef PG8_SA
#undef PG8_SB
#undef PG8_STAGE
#undef PG8_LDA
#undef PG8_LDB
#undef PG8_MMA
#undef PG8_WAIT_V
#undef PG8_WAIT_L
#undef PG8_BAR
#undef PG8_SCHED
}
}

typedef unsigned short u16;
typedef short bf16x8 __attribute__((ext_vector_type(8)));
typedef short s16x4 __attribute__((ext_vector_type(4)));
typedef float f32x4 __attribute__((ext_vector_type(4)));
typedef float f32x16 __attribute__((ext_vector_type(16)));
typedef unsigned u32x4 __attribute__((ext_vector_type(4)));
typedef unsigned u32x2 __attribute__((ext_vector_type(2)));

constexpr int S_ = 16384, DM = 2048, NIN = 16384, DCAT = 4096;
constexpr int NTHR = 512;
constexpr int LDS_BYTES = 131072;
constexpr size_t MiB = (size_t)1 << 20;
constexpr size_t WS_LX = 0;
constexpr size_t WS_Q = 64 * MiB;
constexpr size_t WS_K = 128 * MiB;
constexpr size_t WS_V = 192 * MiB;
constexpr size_t WS_G = 256 * MiB;
constexpr size_t WS_WOUT = 384 * MiB;
constexpr size_t WS_WRG = 400 * MiB;
constexpr size_t WS_WIG = 400 * MiB + 512 * 1024;
constexpr size_t WS_AGG = 401 * MiB;
constexpr size_t WS_ROWSS = 402 * MiB;
constexpr size_t WS_BAR = 404 * MiB;
constexpr size_t WS_END = 405 * MiB;
constexpr int LRU_FLAG0 = 3456;
constexpr float LOG2E = 1.4426950408889634f, LN2 = 0.6931471805599453f;
constexpr float QSCALE = 0.08838834764831845f * 1.4426950408889634f;

struct Params {
    const float *x, *norm_g, *w_in, *conv_w, *conv_b, *w_rg, *b_rg, *w_ig, *b_ig, *lam, *b_merge, *w_out, *final_g;
    float* out; unsigned char* ws; int ph_lo, ph_hi;
};

#define DI __device__ __forceinline__
DI float bf2f(u16 b) { return __uint_as_float(((unsigned)b) << 16); }
DI float fexp2(float x) { return __builtin_amdgcn_exp2f(x); }
DI float flog2(float x) { return __builtin_amdgcn_logf(x); }
DI float frcp(float x) { return __builtin_amdgcn_rcpf(x); }
DI float wave_sum(float v) { v += __shfl_xor(v, 32); v += __shfl_xor(v, 16); v += __shfl_xor(v, 8); v += __shfl_xor(v, 4); v += __shfl_xor(v, 2); v += __shfl_xor(v, 1); return v; }
#define MFMA32(a, b, c) __builtin_amdgcn_mfma_f32_32x32x16_bf16((a), (b), (c), 0, 0, 0)
DI int crow(int reg, int h) { return (reg & 3) + 8 * (reg >> 2) + 4 * h; }

DI int mapcol(int n) {
    const int seg = n >> 11, c = n & 2047, pr = (c >> 7) * 256 + (c & 127);
    switch (seg) {
        case 0: return c;
        case 1: return 2048 + pr;
        case 2: return 6144 + c;
        case 3: return 8192 + c;
        case 4: return 10240 + c;
        case 5: return 12288 + pr;
        case 6: return 2048 + pr + 128;
        default: return 12288 + pr + 128;
    }
}
DI void tr_tile(const float* src, size_t sp, u16* dst, size_t dp, float* t, float scale) {
    const int tid = threadIdx.x;
#pragma unroll
    for (int ps = 0; ps < 2; ++ps) {
        const int r = ps * 32 + (tid >> 4), c4 = (tid & 15) * 4;
        const f32x4 v = *(const f32x4*)(src + (size_t)r * sp + c4);
        t[r * 65 + c4] = v[0]; t[r * 65 + c4 + 1] = v[1]; t[r * 65 + c4 + 2] = v[2]; t[r * 65 + c4 + 3] = v[3];
    }
    __syncthreads();
    const int c = tid >> 3, r8 = (tid & 7) * 8;
    u32x4 w;
    w[0] = pg8::cvt_pk_bf16(t[(r8 + 0) * 65 + c] * scale, t[(r8 + 1) * 65 + c] * scale);
    w[1] = pg8::cvt_pk_bf16(t[(r8 + 2) * 65 + c] * scale, t[(r8 + 3) * 65 + c] * scale);
    w[2] = pg8::cvt_pk_bf16(t[(r8 + 4) * 65 + c] * scale, t[(r8 + 5) * 65 + c] * scale);
    w[3] = pg8::cvt_pk_bf16(t[(r8 + 6) * 65 + c] * scale, t[(r8 + 7) * 65 + c] * scale);
    *(u32x4*)(dst + (size_t)c * dp + r8) = w;
    __syncthreads();
}

template <bool MAPN>
DI void tr_tile256(const float* src, size_t sp, u16* dst, size_t dp, int n0, float* t) {
    const int tid = threadIdx.x;
    f32x4 v[8];
#pragma unroll
    for (int i = 0; i < 8; ++i) v[i] = __builtin_nontemporal_load((const f32x4*)(src + (size_t)(i * 8 + (tid >> 6)) * sp + (tid & 63) * 4));
#pragma unroll
    for (int i = 0; i < 8; ++i) {
        float* q = t + (i * 8 + (tid >> 6)) * 257 + (tid & 63) * 4;
        q[0] = v[i][0]; q[1] = v[i][1]; q[2] = v[i][2]; q[3] = v[i][3];
    }
    __syncthreads();
    const int n = tid >> 1, kh = (tid & 1) * 32;
    const int nd = MAPN ? mapcol(n0 + n) : (n0 + n);
    u16* drow = dst + (size_t)nd * dp + kh;
    float f[32];
#pragma unroll
    for (int i = 0; i < 32; ++i) f[i] = t[(kh + i) * 257 + n];
#pragma unroll
    for (int c = 0; c < 4; ++c) {
        u32x4 w;
        w[0] = pg8::cvt_pk_bf16(f[8 * c], f[8 * c + 1]); w[1] = pg8::cvt_pk_bf16(f[8 * c + 2], f[8 * c + 3]);
        w[2] = pg8::cvt_pk_bf16(f[8 * c + 4], f[8 * c + 5]); w[3] = pg8::cvt_pk_bf16(f[8 * c + 6], f[8 * c + 7]);
        *(u32x4*)(drow + c * 8) = w;
    }
    __syncthreads();
}

DI void p0_prep(const Params& p, unsigned char* smem) {
    const int tid = threadIdx.x, lane = tid & 63, wave = tid >> 6;
    u16* HB = (u16*)p.out;
    u16* WINT = (u16*)((unsigned char*)p.out + 64 * MiB);
    u16* WOUT = (u16*)(p.ws + WS_WOUT);
    u16* WRG = (u16*)(p.ws + WS_WRG);
    u16* WIG = (u16*)(p.ws + WS_WIG);
    f32x4 gn[8];
#pragma unroll
    for (int i = 0; i < 8; ++i) gn[i] = ((const f32x4*)p.norm_g)[i * 64 + lane];
    for (int row = blockIdx.x * 8 + wave; row < S_; row += gridDim.x * 8) {
        const f32x4* xr = (const f32x4*)(p.x + (size_t)row * DM);
        f32x4 v[8]; float ss = 0.f;
#pragma unroll
        for (int i = 0; i < 8; ++i) { v[i] = __builtin_nontemporal_load(xr + i * 64 + lane); ss += v[i][0] * v[i][0] + v[i][1] * v[i][1] + v[i][2] * v[i][2] + v[i][3] * v[i][3]; }
        ss = wave_sum(ss);
        const float rstd = rsqrtf(ss * (1.0f / DM) + 1e-6f);
#pragma unroll
        for (int i = 0; i < 8; ++i) {
            const f32x4 g = gn[i];
            u32x2 o; o[0] = pg8::cvt_pk_bf16(v[i][0] * rstd * g[0], v[i][1] * rstd * g[1]); o[1] = pg8::cvt_pk_bf16(v[i][2] * rstd * g[2], v[i][3] * rstd * g[3]);
            *(u32x2*)(HB + (size_t)row * DM + (i * 64 + lane) * 4) = o;
        }
    }
    float* t = (float*)smem;
    constexpr int T_WIN = 32 * 64, T_WOUT = 64 * 8, T_G = 64;
    for (int ti = blockIdx.x; ti < T_WIN + T_WOUT + 2 * T_G; ti += gridDim.x) {
        if (ti < T_WIN) {
            const int tk = ti & 31, tn = ti >> 5;
            tr_tile256<true>(p.w_in + (size_t)(tk * 64) * NIN + tn * 256, NIN, WINT + tk * 64, DM, tn * 256, t);
        } else if (ti < T_WIN + T_WOUT) {
            const int u = ti - T_WIN, tc = u & 63, td = u >> 6;
            tr_tile256<false>(p.w_out + (size_t)(tc * 64) * DM + td * 256, DM, WOUT + tc * 64, DCAT, td * 256, t);
        } else {
            int u = ti - T_WIN - T_WOUT; const float* src = p.w_rg; u16* dst = WRG;
            if (u >= T_G) { u -= T_G; src = p.w_ig; dst = WIG; }
            const int b = u >> 2, ti2 = (u >> 1) & 1, tj = u & 1;
            tr_tile(src + (size_t)b * 16384 + (ti2 * 64) * 128 + tj * 64, 128, dst + (size_t)b * 16384 + (tj * 64) * 128 + ti2 * 64, 128, t, -LOG2E);
        }
    }
}

struct EpiProj {
    static constexpr bool PERM = true, AFTER_DRAIN = false;
    u16 *LX, *Q, *K, *V, *G; const float* bm;
    DI void operator()(const f32x4 (&acc)[2][2][4][2], const pg8::Unit& u, int wr, int wc, int fr, int fq) const {
        const int pn = u.pn, row0 = u.pm * 256 + wr * 64 + fr, cl = wc * 32 + 8 * fq;
        if ((pn >= 8 && pn < 24) || pn >= 48) {
            const int gbase = (pn >= 48 ? 2048 + (pn - 48) * 128 : (pn - 8) * 128) + cl;
            const f32x4 b0 = *(const f32x4*)(bm + gbase), b1 = *(const f32x4*)(bm + gbase + 4);
#pragma unroll
            for (int ai = 0; ai < 2; ++ai)
#pragma unroll
                for (int m = 0; m < 4; ++m) {
                    const f32x4 g0 = acc[ai][0][m][0], g1 = acc[ai][0][m][1];
                    const f32x4 m0 = acc[ai][1][m][0] + b0, m1 = acc[ai][1][m][1] + b1;
                    float o[8];
#pragma unroll
                    for (int e = 0; e < 4; ++e) {
                        o[e] = g0[e] * frcp((1.0f + fexp2(-g0[e] * LOG2E)) * (1.0f + fexp2(-m0[e] * LOG2E)));
                        o[4 + e] = g1[e] * frcp((1.0f + fexp2(-g1[e] * LOG2E)) * (1.0f + fexp2(-m1[e] * LOG2E)));
                    }
                    u32x4 w; w[0] = pg8::cvt_pk_bf16(o[0], o[1]); w[1] = pg8::cvt_pk_bf16(o[2], o[3]); w[2] = pg8::cvt_pk_bf16(o[4], o[5]); w[3] = pg8::cvt_pk_bf16(o[6], o[7]);
                    *(u32x4*)(G + (size_t)(row0 + ai * 128 + m * 16) * DCAT + gbase) = w;
                }
        } else {
            u16* base; int colt; float sc = 1.0f;
            if (pn < 8) { base = LX; colt = pn * 256; }
            else if (pn < 32) { base = Q; colt = (pn - 24) * 256; sc = QSCALE; }
            else if (pn < 40) { base = K; colt = (pn - 32) * 256; }
            else { base = V; colt = (pn - 40) * 256; }
#pragma unroll
            for (int ai = 0; ai < 2; ++ai)
#pragma unroll
                for (int m = 0; m < 4; ++m)
#pragma unroll
                    for (int bj = 0; bj < 2; ++bj) {
                        const f32x4 v0 = acc[ai][bj][m][0] * sc, v1 = acc[ai][bj][m][1] * sc;
                        u32x4 w; w[0] = pg8::cvt_pk_bf16(v0[0], v0[1]); w[1] = pg8::cvt_pk_bf16(v0[2], v0[3]); w[2] = pg8::cvt_pk_bf16(v1[0], v1[1]); w[3] = pg8::cvt_pk_bf16(v1[2], v1[3]);
                        *(u32x4*)(base + (size_t)(row0 + ai * 128 + m * 16) * DM + colt + bj * 128 + cl) = w;
                    }
        }
    }
};

struct EpiOut {
    static constexpr bool PERM = false, AFTER_DRAIN = false;
    const float* x; float* out; float* rowss;
    DI void operator()(const f32x4 (&acc)[2][2][4][2], const pg8::Unit& u, int wr, int wc, int fr, int fq) const {
        const int row0 = u.pm * 256 + wr * 64 + fr, col0 = u.pn * 256 + wc * 32 + 4 * fq;
#pragma unroll
        for (int ai = 0; ai < 2; ++ai)
#pragma unroll
            for (int m = 0; m < 4; ++m) {
                const int row = row0 + ai * 128 + m * 16; float ss = 0.f;
#pragma unroll
                for (int bj = 0; bj < 2; ++bj)
#pragma unroll
                    for (int n = 0; n < 2; ++n) {
                        const size_t off = (size_t)row * DM + col0 + bj * 128 + n * 16;
                        const f32x4 v = *(const f32x4*)(x + off) + acc[ai][bj][m][n];
                        *(f32x4*)(out + off) = v;
                        ss += v[0] * v[0] + v[1] * v[1] + v[2] * v[2] + v[3] * v[3];
                    }
                ss += __shfl_xor(ss, 16); ss += __shfl_xor(ss, 32);
                if (fq == 0) rowss[(size_t)row * 32 + u.pn * 4 + wc] = ss;
            }
    }
};

constexpr int LRU_XCB = 0, LRU_XCF = 17408, LRU_AB = 17408 + 32768, LRU_PARTS = 17408 + 65536;
template <bool FINAL>
DI void lru_unit(const Params& p, unsigned char* smem, int chunk, int blk, u16* Gdst) {
    const int tid = threadIdx.x, lane = tid & 63, wave = tid >> 6;
    const u16* LX = (const u16*)(p.ws + WS_LX);
    const u16* G = (const u16*)(p.ws + WS_G);
    float* AGG = (float*)(p.ws + WS_AGG);
    u16* xcb = (u16*)(smem + LRU_XCB);
    float* xcf = (float*)(smem + LRU_XCF);
    float* hbuf = (float*)(smem + LRU_AB);
    float* gp = (float*)(smem + LRU_PARTS);
    const int th = wave >> 2, cq = wave & 3, rr = lane & 31, h = lane >> 5, j = cq * 32 + rr, ch = blk * 128 + j;
    bf16x8 wrg[8], wig[8];
    {
        const u16* WRG = (const u16*)(p.ws + WS_WRG) + (size_t)blk * 16384 + j * 128 + 8 * h;
        const u16* WIG = (const u16*)(p.ws + WS_WIG) + (size_t)blk * 16384 + j * 128 + 8 * h;
#pragma unroll
        for (int ks = 0; ks < 8; ++ks) { wrg[ks] = *(const bf16x8*)(WRG + ks * 16); wig[ks] = *(const bf16x8*)(WIG + ks * 16); }
    }
    const float brg = -p.b_rg[ch] * LOG2E, big = -p.b_ig[ch] * LOG2E;
    const float c2 = -8.0f * log1pf(expf(-p.lam[ch])) * LOG2E;
    const int cc = (tid & 63) * 2, tg = tid >> 6, cch = blk * 128 + cc;
    float cw[4][2], cb[2];
#pragma unroll
    for (int tap = 0; tap < 4; ++tap) { cw[tap][0] = p.conv_w[tap * DM + cch]; cw[tap][1] = p.conv_w[tap * DM + cch + 1]; }
    cb[0] = p.conv_b[cch]; cb[1] = p.conv_b[cch + 1];
    const int etok = tid >> 4, ech8 = (tid & 15) * 8;
    float h_run = 0.f, a_run = 1.f;
    if (FINAL) {
        if (wave == 0 && lane < chunk) {
            const unsigned* fl = (const unsigned*)(p.ws + WS_BAR) + LRU_FLAG0 + lane * 16 + blk;
            unsigned sp = 0;
            while (__hip_atomic_load(fl, __ATOMIC_RELAXED, __HIP_MEMORY_SCOPE_AGENT) == 0u && ++sp < (1u << 22)) __builtin_amdgcn_s_sleep(2);
        }
        __syncthreads();
        float An[15], Bn[15];
#pragma unroll
        for (int n = 0; n < 15; ++n) {
            An[n] = 1.f; Bn[n] = 0.f;
            if (n < chunk) {
                An[n] = __uint_as_float(__hip_atomic_load((const unsigned*)AGG + (size_t)(n * 2) * DM + ch, __ATOMIC_RELAXED, __HIP_MEMORY_SCOPE_AGENT));
                Bn[n] = __uint_as_float(__hip_atomic_load((const unsigned*)AGG + (size_t)(n * 2 + 1) * DM + ch, __ATOMIC_RELAXED, __HIP_MEMORY_SCOPE_AGENT));
            }
        }
#pragma unroll
        for (int n = 0; n < 15; ++n) h_run = An[n] * h_run + Bn[n];
    }
    unsigned lxn[11];
#define LRU_LXLOAD(T0) do { _Pragma("unroll") for (int r_ = 0; r_ < 11; ++r_) { const int tok_ = (T0) + tg * 8 - 3 + r_; \
        lxn[r_] = (tok_ >= 0) ? *(const unsigned*)(LX + (size_t)tok_ * DM + cch) : 0u; } } while (0)
    LRU_LXLOAD(chunk * 1024);
    for (int st = 0; st < 16; ++st) {
        const int t0 = chunk * 1024 + st * 64;
        float xv[11][2];
#pragma unroll
        for (int r = 0; r < 11; ++r) { xv[r][0] = __uint_as_float(lxn[r] << 16); xv[r][1] = __uint_as_float(lxn[r] & 0xffff0000u); }
        if (st < 15) LRU_LXLOAD(t0 + 64);
        u32x4 gq[2];
        if (FINAL) {
#pragma unroll
            for (int k = 0; k < 2; ++k) gq[k] = *(const u32x4*)(G + (size_t)(t0 + k * 32 + etok) * DCAT + blk * 128 + ech8);
        }
#pragma unroll
        for (int q = 0; q < 8; ++q) {
            float y0 = cb[0], y1 = cb[1];
#pragma unroll
            for (int tap = 0; tap < 4; ++tap) { y0 += xv[q + tap][0] * cw[tap][0]; y1 += xv[q + tap][1] * cw[tap][1]; }
            const int tok = tg * 8 + q;
            *(unsigned*)(xcb + tok * 136 + cc) = pg8::cvt_pk_bf16(y0, y1);
            xcf[tok * 128 + cc] = y0; xcf[tok * 128 + cc + 1] = y1;
        }
        __syncthreads();
        float av[16], uv[16];
        {
            f32x16 ar, ai;
#pragma unroll
            for (int i = 0; i < 16; ++i) { ar[i] = brg; ai[i] = big; }
            bf16x8 af[8];
#pragma unroll
            for (int ks = 0; ks < 8; ++ks) af[ks] = *(const bf16x8*)(xcb + (th * 32 + rr) * 136 + ks * 16 + 8 * h);
            float xq[16];
#pragma unroll
            for (int i = 0; i < 16; ++i) xq[i] = xcf[(th * 32 + crow(i, h)) * 128 + j];
#pragma unroll
            for (int ks = 0; ks < 8; ++ks) { ar = MFMA32(af[ks], wrg[ks], ar); ai = MFMA32(af[ks], wig[ks], ai); }
#pragma unroll
            for (int i = 0; i < 16; ++i) {
                const float xvv = xq[i];
                const float e1 = fexp2(ar[i]), e2 = fexp2(ai[i]);
                const float r = frcp(1.0f + e1), ig = frcp(1.0f + e2);
                const float a = fexp2(r * c2);
                av[i] = a;
                uv[i] = __builtin_amdgcn_sqrtf(fmaf(-a, a, 1.0f)) * (ig * xvv);
            }
#pragma unroll
            for (int g = 0; g < 4; ++g) {
                float A = av[4 * g], B = uv[4 * g];
#pragma unroll
                for (int e2 = 1; e2 < 4; ++e2) { B = av[4 * g + e2] * B + uv[4 * g + e2]; A *= av[4 * g + e2]; }
                gp[(th * 8 + 2 * g + h) * 128 + j] = A; gp[2048 + (th * 8 + 2 * g + h) * 128 + j] = B;
            }
        }
        __syncthreads();
        {
            float hin[4] = {0.f, 0.f, 0.f, 0.f};
            float hr = h_run;
#pragma unroll
            for (int t2 = 0; t2 < 2; ++t2)
#pragma unroll
                for (int g2 = 0; g2 < 4; ++g2)
#pragma unroll
                    for (int h2 = 0; h2 < 2; ++h2) {
                        const int Gi = t2 * 8 + 2 * g2 + h2;
                        hin[g2] = (t2 == th && h2 == h) ? hr : hin[g2];
                        const float A = gp[Gi * 128 + j], B = gp[2048 + Gi * 128 + j];
                        hr = A * hr + B; a_run *= A;
                    }
            h_run = hr;
            if (FINAL) {
#pragma unroll
                for (int g = 0; g < 4; ++g) {
                    float hh = hin[g];
#pragma unroll
                    for (int e2 = 0; e2 < 4; ++e2) { hh = av[4 * g + e2] * hh + uv[4 * g + e2]; hbuf[(th * 32 + 8 * g + 4 * h + e2) * 128 + j] = hh; }
                }
            }
        }
        if (FINAL) {
            __syncthreads();
#pragma unroll
            for (int k = 0; k < 2; ++k) {
                const f32x4 h0 = *(const f32x4*)(hbuf + (k * 32 + etok) * 128 + ech8), h1 = *(const f32x4*)(hbuf + (k * 32 + etok) * 128 + ech8 + 4);
                u32x4 w;
                w[0] = pg8::cvt_pk_bf16(h0[0] * __uint_as_float(gq[k][0] << 16), h0[1] * __uint_as_float(gq[k][0] & 0xffff0000u));
                w[1] = pg8::cvt_pk_bf16(h0[2] * __uint_as_float(gq[k][1] << 16), h0[3] * __uint_as_float(gq[k][1] & 0xffff0000u));
                w[2] = pg8::cvt_pk_bf16(h1[0] * __uint_as_float(gq[k][2] << 16), h1[1] * __uint_as_float(gq[k][2] & 0xffff0000u));
                w[3] = pg8::cvt_pk_bf16(h1[2] * __uint_as_float(gq[k][3] << 16), h1[3] * __uint_as_float(gq[k][3] & 0xffff0000u));
                *(u32x4*)(Gdst + (size_t)(t0 + k * 32 + etok) * DCAT + blk * 128 + ech8) = w;
            }
        }
    }
#undef LRU_LXLOAD
    __syncthreads();
    if (!FINAL) {
        if (wave < 4 && h == 0) {
            __hip_atomic_store((unsigned*)AGG + (size_t)(chunk * 2) * DM + ch, __float_as_uint(a_run), __ATOMIC_RELAXED, __HIP_MEMORY_SCOPE_AGENT);
            __hip_atomic_store((unsigned*)AGG + (size_t)(chunk * 2 + 1) * DM + ch, __float_as_uint(h_run), __ATOMIC_RELAXED, __HIP_MEMORY_SCOPE_AGENT);
        }
        asm volatile("s_waitcnt vmcnt(0)" ::: "memory");
        __syncthreads();
        if (tid == 0) __hip_atomic_store((unsigned*)(p.ws + WS_BAR) + LRU_FLAG0 + chunk * 16 + blk, 1u, __ATOMIC_RELAXED, __HIP_MEMORY_SCOPE_AGENT);
    }
}

constexpr int ATT_K = 0, ATT_V = 17408;
typedef __attribute__((address_space(3))) s16x4 lds_s16x4;
template <bool MASK>
DI void sb_weights(const f32x16& z, int kb, int query, int h, float& rem, float (&pw)[16]) {
    float be[16], om[16];
#pragma unroll
    for (int i = 0; i < 16; ++i) {
        const float b = frcp(1.0f + fexp2(-z[i]));
        if (MASK) { const bool valid = (kb + crow(i, h)) < query; be[i] = valid ? b : 0.f; om[i] = valid ? 1.0f - b : 1.0f; }
        else { be[i] = b; om[i] = 1.0f - b; }
    }
    float T[4], To[4], ex[16];
#pragma unroll
    for (int g = 0; g < 4; ++g) {
        ex[4 * g + 3] = 1.0f; ex[4 * g + 2] = om[4 * g + 3]; ex[4 * g + 1] = ex[4 * g + 2] * om[4 * g + 2]; ex[4 * g] = ex[4 * g + 1] * om[4 * g + 1];
        T[g] = ex[4 * g] * om[4 * g];
        To[g] = __shfl_xor(T[g], 32);
    }
    float Sg[4]; float suf = rem;
#pragma unroll
    for (int g = 3; g >= 0; --g) { Sg[g] = (h == 0) ? suf * To[g] : suf; suf *= T[g] * To[g]; }
#pragma unroll
    for (int i = 0; i < 16; ++i) pw[i] = be[i] * (Sg[i >> 2] * ex[i]);
    rem = suf;
}
DI bf16x8 pack8(const float* v) {
    u32x4 w; w[0] = pg8::cvt_pk_bf16(v[0], v[1]); w[1] = pg8::cvt_pk_bf16(v[2], v[3]); w[2] = pg8::cvt_pk_bf16(v[4], v[5]); w[3] = pg8::cvt_pk_bf16(v[6], v[7]);
    return __builtin_bit_cast(bf16x8, w);
}
DI void attn_unit(const Params& p, unsigned char* smem, int hd, int qb, u16* Gdst) {
    const int tid = threadIdx.x, lane = tid & 63, wave = tid >> 6;
    const u16* Qg = (const u16*)(p.ws + WS_Q);
    const u16* Kg = (const u16*)(p.ws + WS_K);
    const u16* Vg = (const u16*)(p.ws + WS_V);
    const u16* G = (const u16*)(p.ws + WS_G);
    u16* Kt = (u16*)(smem + ATT_K);
    u16* Vt = (u16*)(smem + ATT_V);
    unsigned* aflags = (unsigned*)(smem + 8 * 8704);
    const int rr = lane & 31, h = lane >> 5, qw = qb * 256 + wave * 32, query = qw + rr;
    const int i16 = lane & 15, q4 = i16 >> 2, p4 = i16 & 3, blk = (lane >> 4) & 1;
    bf16x8 qf[8];
    {
        const u16* qp = Qg + (size_t)query * DM + hd * 128 + 8 * h;
#pragma unroll
        for (int ks = 0; ks < 8; ++ks) qf[ks] = *(const bf16x8*)(qp + ks * 16);
    }
    f32x16 o[4];
#pragma unroll
    for (int d = 0; d < 4; ++d)
#pragma unroll
        for (int i = 0; i < 16; ++i) o[d][i] = 0.f;
    float rem = 1.0f; bool done = false;
    const int lk0 = tid >> 4, lp = tid & 15;
    u32x4 kr[2], vr[2];
    const int kt_hi = qb * 4 + 3;
    const u16* kp = Kt + rr * 136 + 8 * h;
    const u16* vp = Vt + (4 * h + q4) * 136 + 16 * blk + 4 * p4;
#define ATT_LOAD(kt) do { _Pragma("unroll") for (int i_ = 0; i_ < 2; ++i_) { const size_t g_ = (size_t)((kt) * 64 + lk0 + i_ * 32) * DM + hd * 128 + lp * 8; \
        kr[i_] = *(const u32x4*)(Kg + g_); vr[i_] = *(const u32x4*)(Vg + g_); } } while (0)
    ATT_LOAD(kt_hi);
    for (int kt = kt_hi; kt >= 0; --kt) {
#pragma unroll
        for (int i = 0; i < 2; ++i) { *(u32x4*)(Kt + (lk0 + i * 32) * 136 + lp * 8) = kr[i]; *(u32x4*)(Vt + (lk0 + i * 32) * 136 + lp * 8) = vr[i]; }
        __syncthreads();
        if (kt > 0) ATT_LOAD(kt - 1);
        if (!done && kt * 64 <= qw) {
            f32x16 z0, z1;
#pragma unroll
            for (int i = 0; i < 16; ++i) { z0[i] = 0.f; z1[i] = 0.f; }
#pragma unroll
            for (int ks = 0; ks < 8; ++ks) {
                const bf16x8 a0 = *(const bf16x8*)(kp + ks * 16), a1 = *(const bf16x8*)(kp + 32 * 136 + ks * 16);
                z0 = MFMA32(a0, qf[ks], z0); z1 = MFMA32(a1, qf[ks], z1);
            }
            bf16x8 pf[4];
            if (kt * 64 + 63 >= qw) {
                { float pw[16]; sb_weights<true>(z1, kt * 64 + 32, query, h, rem, pw); pf[2] = pack8(pw); pf[3] = pack8(pw + 8); }
                __builtin_amdgcn_sched_barrier(0);
                { float pw[16]; sb_weights<true>(z0, kt * 64, query, h, rem, pw); pf[0] = pack8(pw); pf[1] = pack8(pw + 8); }
            } else {
                { float pw[16]; sb_weights<false>(z1, kt * 64 + 32, query, h, rem, pw); pf[2] = pack8(pw); pf[3] = pack8(pw + 8); }
                __builtin_amdgcn_sched_barrier(0);
                { float pw[16]; sb_weights<false>(z0, kt * 64, query, h, rem, pw); pf[0] = pack8(pw); pf[1] = pack8(pw + 8); }
            }
            __builtin_amdgcn_sched_barrier(0);
            bf16x8 vf[2][4];
#define ATT_VLD(s_, buf_) do { _Pragma("unroll") for (int d_ = 0; d_ < 4; ++d_) { \
                    const s16x4 lo_ = __builtin_amdgcn_ds_read_tr16_b64_v4i16((lds_s16x4*)(vp + (16 * (s_)) * 136 + d_ * 32)); \
                    const s16x4 hi_ = __builtin_amdgcn_ds_read_tr16_b64_v4i16((lds_s16x4*)(vp + (16 * (s_) + 8) * 136 + d_ * 32)); \
                    vf[buf_][d_] = __builtin_shufflevector(lo_, hi_, 0, 1, 2, 3, 4, 5, 6, 7); } } while (0)
            ATT_VLD(0, 0);
            __builtin_amdgcn_sched_barrier(0);
#pragma unroll
            for (int s = 0; s < 4; ++s) {
                if (s + 1 < 4) { if ((s + 1) & 1) ATT_VLD(s + 1, 1); else ATT_VLD(s + 1, 0); }
                __builtin_amdgcn_sched_barrier(0);
#pragma unroll
                for (int d = 0; d < 4; ++d) o[d] = MFMA32(vf[s & 1][d], pf[s], o[d]);
                __builtin_amdgcn_sched_barrier(0);
            }
#undef ATT_VLD
            done = (__ballot(rem != 0.0f) == 0ull);
        }
        if (lane == 0) aflags[wave] = done ? 1u : 0u;
        __syncthreads();
        {
            const u32x4 f0 = *(const u32x4*)aflags, f1 = *(const u32x4*)(aflags + 4);
            if ((f0[0] & f0[1] & f0[2] & f0[3] & f1[0] & f1[1] & f1[2] & f1[3]) != 0u) break;
        }
    }
#undef ATT_LOAD
    {
        const int er = lane >> 4, ep = lane & 15;
        u32x4 gv[8];
#pragma unroll
        for (int i = 0; i < 8; ++i) gv[i] = *(const u32x4*)(G + (size_t)(qw + i * 4 + er) * DCAT + 2048 + hd * 128 + ep * 8);
        unsigned char* ot = smem + wave * 8704;
#pragma unroll
        for (int d = 0; d < 4; ++d)
#pragma unroll
            for (int g = 0; g < 4; ++g) {
                u32x2 w; w[0] = pg8::cvt_pk_bf16(o[d][4 * g], o[d][4 * g + 1]); w[1] = pg8::cvt_pk_bf16(o[d][4 * g + 2], o[d][4 * g + 3]);
                *(u32x2*)(ot + rr * 272 + (d * 32 + 8 * g + 4 * h) * 2) = w;
            }
#pragma unroll
        for (int i = 0; i < 8; ++i) {
            const u32x4 ov = *(const u32x4*)(ot + (i * 4 + er) * 272 + ep * 16);
            u32x4 w;
#pragma unroll
            for (int e = 0; e < 4; ++e)
                w[e] = pg8::cvt_pk_bf16(__uint_as_float(ov[e] << 16) * __uint_as_float(gv[i][e] << 16), __uint_as_float(ov[e] & 0xffff0000u) * __uint_as_float(gv[i][e] & 0xffff0000u));
            *(u32x4*)(Gdst + (size_t)(qw + i * 4 + er) * DCAT + 2048 + hd * 128 + ep * 8) = w;
        }
    }
    __syncthreads();
}


#include <vector>

#define XB_TMO      128
#define XB_XCNT(j)  (256  + 64 * (j))
#define XB_XSUB(j)  (1280 + 64 * (j))
#define XB_XGEN(j)  (2304 + 64 * (j))
#define XB_TOP      3328
#define XB_TOPGEN   3392
#define XCD_BAR_WORDS 3456
#define XB_SPIN_CAP (1u << 18)
#define LAS __attribute__((address_space(3)))

__device__ __forceinline__ unsigned xb_ld(unsigned* p)              { return __hip_atomic_load(p, __ATOMIC_RELAXED, __HIP_MEMORY_SCOPE_AGENT); }
__device__ __forceinline__ unsigned xb_add(unsigned* p, unsigned v) { return __hip_atomic_fetch_add(p, v, __ATOMIC_RELAXED, __HIP_MEMORY_SCOPE_AGENT); }
__device__ __forceinline__ unsigned xb_xcc_id() { return (unsigned)__builtin_amdgcn_s_getreg((3 << 11) | 20) & 0xFu; }
#define XB_SPIN(cond, bar) do { unsigned _sp = 0; while (cond) { __builtin_amdgcn_s_sleep(1); \
    if ((++_sp & 255u) == 0u) { if (xb_ld(&(bar)[XB_TMO])) break; if (_sp > XB_SPIN_CAP) { atomicAdd(&(bar)[XB_TMO], 1u); break; } } } } while (0)

static_assert(LRU_FLAG0 == XCD_BAR_WORDS, "LRU flags sit right behind the barrier words");
struct XcdBarrier {
    unsigned* bar; unsigned x;
    volatile LAS unsigned* st;
};

__device__ __forceinline__ XcdBarrier xcd_barrier_post(unsigned* bar, volatile LAS unsigned* st) {
    XcdBarrier b; b.bar = bar; b.x = xb_xcc_id(); b.st = st;
    if (threadIdx.x == 0) (void)xb_add(&bar[XB_XCNT(b.x)], 1u);
    return b;
}
__device__ __forceinline__ void xcd_barrier_complete(unsigned* bar, unsigned x, unsigned& nloc, unsigned& nx) {
    const unsigned G = gridDim.x * gridDim.y * gridDim.z;
    unsigned sum, cnt, mine, sp = 0u;
    for (;;) {
        sum = 0u; cnt = 0u; mine = 0u;
#pragma unroll
        for (unsigned j = 0; j < 16; ++j) { const unsigned c = xb_ld(&bar[XB_XCNT(j)]); sum += c; cnt += (c > 0u) ? 1u : 0u; mine = (j == x) ? c : mine; }
        if (sum == G) break;
        __builtin_amdgcn_s_sleep(1);
        if ((++sp & 255u) == 0u) { if (xb_ld(&bar[XB_TMO])) break; if (sp > XB_SPIN_CAP) { atomicAdd(&bar[XB_TMO], 1u); break; } }
    }
    nloc = mine > 0u ? mine : 1u; nx = cnt > 0u ? cnt : 1u;
}

__device__ __forceinline__ void xcd_barrier(const XcdBarrier& b) {
    asm volatile("s_waitcnt vmcnt(0)" ::: "memory");
    __syncthreads();
    if (threadIdx.x == 0) {
        unsigned* bar = b.bar;
        __builtin_amdgcn_s_waitcnt(0);
        unsigned nloc = b.st[0], nx = b.st[1];
        if (nloc == 0u) { xcd_barrier_complete(bar, b.x, nloc, nx); b.st[0] = nloc; b.st[1] = nx; }
        const unsigned old = xb_add(&bar[XB_XSUB(b.x)], 1u);
        const unsigned gen = old / nloc;
        if (old + 1u == (gen + 1u) * nloc) {
            __builtin_amdgcn_fence(__ATOMIC_RELEASE, "agent");
            asm volatile("s_waitcnt vmcnt(0)" ::: "memory");
            const unsigned og = xb_add(&bar[XB_TOP], 1u);
            const unsigned tg = og / nx;
            if (og + 1u == (tg + 1u) * nx) xb_add(&bar[XB_TOPGEN], 1u);
            else XB_SPIN(xb_ld(&bar[XB_TOPGEN]) == tg, bar);
            __builtin_amdgcn_fence(__ATOMIC_ACQUIRE, "agent");
            xb_add(&bar[XB_XGEN(b.x)], 1u);
            asm volatile("s_waitcnt vmcnt(0)" ::: "memory");
        } else {
            XB_SPIN(xb_ld(&bar[XB_XGEN(b.x)]) == gen, bar);
            __builtin_amdgcn_fence(__ATOMIC_ACQUIRE, "agent");
            asm volatile("s_waitcnt vmcnt(0)" ::: "memory");
        }
    }
    __syncthreads();
}


struct EpiOutF {
    static constexpr bool PERM = false, AFTER_DRAIN = true;
    const float* x; float* out; float* rowss; const float* fg; XcdBarrier xb; int G, c;
    template <bool KEEP>
    DI void add_residual(f32x4 (&acc)[2][2][4][2], const pg8::Unit& u, int wr, int wc, int fr, int fq) const {
        const int row0 = u.pm * 256 + wr * 64 + fr, col0 = u.pn * 256 + wc * 32 + 4 * fq;
        f32x4 xb[2][2][2][2];
#define RES_LOAD(q_, b_) do { _Pragma("unroll") for (int mm_ = 0; mm_ < 2; ++mm_) _Pragma("unroll") for (int bj_ = 0; bj_ < 2; ++bj_) _Pragma("unroll") for (int n_ = 0; n_ < 2; ++n_) \
            xb[b_][mm_][bj_][n_] = __builtin_nontemporal_load((const f32x4*)(x + (size_t)(row0 + ((q_) >> 1) * 128 + (2 * ((q_) & 1) + mm_) * 16) * DM + col0 + bj_ * 128 + n_ * 16)); } while (0)
        RES_LOAD(0, 0);
        RES_LOAD(1, 1);
#pragma unroll
        for (int q = 0; q < 4; ++q) {
            const int ai = q >> 1;
#pragma unroll
            for (int mm = 0; mm < 2; ++mm) {
                const int m = 2 * (q & 1) + mm, row = row0 + ai * 128 + m * 16; float ss = 0.f;
#pragma unroll
                for (int bj = 0; bj < 2; ++bj)
#pragma unroll
                    for (int n = 0; n < 2; ++n) {
                        const f32x4 v = xb[q & 1][mm][bj][n] + acc[ai][bj][m][n];
                        if (KEEP) acc[ai][bj][m][n] = v; else *(f32x4*)(out + (size_t)row * DM + col0 + bj * 128 + n * 16) = v;
                        ss += v[0] * v[0] + v[1] * v[1] + v[2] * v[2] + v[3] * v[3];
                    }
                ss += __shfl_xor(ss, 16); ss += __shfl_xor(ss, 32);
                if (fq == 0) rowss[(size_t)row * 32 + u.pn * 4 + wc] = ss;
            }
            if (q + 2 < 4) { if (q & 1) RES_LOAD(q + 2, 1); else RES_LOAD(q + 2, 0); }
        }
#undef RES_LOAD
    }
    DI void operator()(const f32x4 (&acc)[2][2][4][2], const pg8::Unit& u, int wr, int wc, int fr, int fq) const {
        add_residual<false>(const_cast<f32x4 (&)[2][2][4][2]>(acc), u, wr, wc, fr, fq);
    }
    DI float row_rstd(int row) const {
        const f32x4* pr = (const f32x4*)(rowss + (size_t)row * 32); float ss = 0.f;
#pragma unroll
        for (int k = 0; k < 8; ++k) { const f32x4 v = pr[k]; ss += (v[0] + v[1]) + (v[2] + v[3]); }
        return rsqrtf(ss * (1.0f / DM) + 1e-6f);
    }
    DI void fused(f32x4 (&acc)[2][2][4][2], const pg8::Unit& u, int wr, int wc, int fr, int fq, PG8_LAS unsigned char* lds, int wid, int lane) const {
        const int row0 = u.pm * 256 + wr * 64 + fr, col0 = u.pn * 256 + wc * 32 + 4 * fq, tid = wid * 64 + lane;
        PG8_LAS float* rs = (PG8_LAS float*)lds;
        add_residual<true>(acc, u, wr, wc, fr, fq);
        f32x4 g4[2][2];
#pragma unroll
        for (int bj = 0; bj < 2; ++bj)
#pragma unroll
            for (int n = 0; n < 2; ++n) g4[bj][n] = *(const f32x4*)(fg + col0 + bj * 128 + n * 16);
        xcd_barrier(xb);
        if (tid < 256) rs[tid] = row_rstd(u.pm * 256 + tid);
        __syncthreads();
#pragma unroll
        for (int bj = 0; bj < 2; ++bj)
#pragma unroll
            for (int n = 0; n < 2; ++n) {
                const f32x4 g = g4[bj][n];
#pragma unroll
                for (int ai = 0; ai < 2; ++ai)
#pragma unroll
                    for (int m = 0; m < 4; ++m) {
                        const float r = rs[ai * 128 + wr * 64 + m * 16 + fr];
                        f32x4 v = acc[ai][bj][m][n];
                        v[0] *= r * g[0]; v[1] *= r * g[1]; v[2] *= r * g[2]; v[3] *= r * g[3];
                        *(f32x4*)(out + (size_t)(row0 + ai * 128 + m * 16) * DM + col0 + bj * 128 + n * 16) = v;
                    }
            }
        pg8::StaticOrder S; S.init(S_, DM, G, c);
        pg8::Unit u0, u1;
        for (int i = 0; S.next(i, u0) && S.next(i + 1, u1); ++i) {
            __syncthreads();
            if (tid < 256) rs[tid] = row_rstd(u0.pm * 256 + tid);
            __syncthreads();
            const f32x4 g = *(const f32x4*)(fg + u0.pn * 256 + lane * 4);
            f32x4 tv[32];
#pragma unroll
            for (int k = 0; k < 32; ++k) tv[k] = *(const f32x4*)(out + (size_t)(u0.pm * 256 + k * 8 + wid) * DM + u0.pn * 256 + lane * 4);
#pragma unroll
            for (int k = 0; k < 32; ++k) {
                const int row = k * 8 + wid; const float r = rs[row];
                f32x4 v = tv[k]; v[0] *= r * g[0]; v[1] *= r * g[1]; v[2] *= r * g[2]; v[3] *= r * g[3];
                *(f32x4*)(out + (size_t)(u0.pm * 256 + row) * DM + u0.pn * 256 + lane * 4) = v;
            }
        }
    }
};

#ifndef N_LAUNCHES
#define N_LAUNCHES 1
#endif
__global__ void __launch_bounds__(NTHR, 2) mega_fwd(Params p) {
    extern __shared__ __attribute__((aligned(16))) unsigned char smem[];
    cg::grid_group grid = cg::this_grid();
    __shared__ uint4 xb_words;
    if (threadIdx.x == 0) xb_words = make_uint4(0u, 0u, 0u, 0u);
    __syncthreads();
    if (p.ph_hi > 1000) grid.sync();
    XcdBarrier xbar = xcd_barrier_post((unsigned*)(p.ws + WS_BAR), (volatile LAS unsigned*)&xb_words);
#define IN(k) (p.ph_lo <= (k) && (k) < p.ph_hi)
#define SEAM(k) do { if (IN(k) && IN((k) + 1)) xcd_barrier(xbar); } while (0)
#ifndef PROBE_PH
#define PROBE_PH -1
#endif
#define REPS(k) ((PROBE_PH == (k)) ? 2 : 1)
    for (int rep = 0; rep < REPS(0); ++rep) { if (IN(0)) p0_prep(p, smem); SEAM(0); }
    {
        if (IN(1)) {
            pg8::Gemm g{(const u16*)p.out, (const u16*)((const unsigned char*)p.out + 64 * MiB), S_, NIN, DM};
            pg8::StaticOrder S; S.init(S_, NIN, (int)gridDim.x, (int)blockIdx.x); S.rep = REPS(1);
            EpiProj E{(u16*)(p.ws + WS_LX), (u16*)(p.ws + WS_Q), (u16*)(p.ws + WS_K), (u16*)(p.ws + WS_V), (u16*)(p.ws + WS_G), p.b_merge};
            pg8::gemm_phase<EpiProj, pg8::StaticOrder, false>((PG8_LAS unsigned char*)smem, g, S, E, nullptr);
        }
        SEAM(1);
    }
    if (IN(2)) {
#pragma unroll 1
        for (int half = 0; half < 2; ++half) {
            if ((half == 0) == ((blockIdx.x >> 3) & 1)) {
                for (int it = blockIdx.x; it < 512; it += gridDim.x) attn_unit(p, smem, it & 15, it >> 4, (u16*)(p.ws + WS_G));
            } else {
                for (int u = blockIdx.x; u < 256; u += gridDim.x) lru_unit<false>(p, smem, u >> 4, u & 15, nullptr);
            }
        }
    }
    if (IN(3)) {
#pragma unroll 1
        for (int half = 0; half < 2; ++half) {
            if ((half == 0) == ((blockIdx.x >> 3) & 1)) {
                for (int it = 512 + blockIdx.x; it < 1024; it += gridDim.x) attn_unit(p, smem, it & 15, it >> 4, (u16*)(p.ws + WS_G));
            } else {
                for (int u = blockIdx.x; u < 256; u += gridDim.x) lru_unit<true>(p, smem, u >> 4, u & 15, (u16*)(p.ws + WS_G));
            }
        }
    }
    SEAM(3);
    if (IN(4)) {
        pg8::Gemm g{(const u16*)(p.ws + WS_G), (const u16*)(p.ws + WS_WOUT), S_, DM, DCAT};
        pg8::StaticOrder S; S.init(S_, DM, (int)gridDim.x, (int)blockIdx.x);
        EpiOutF E{p.x, p.out, (float*)(p.ws + WS_ROWSS), p.final_g, xbar, (int)gridDim.x, (int)blockIdx.x};
        pg8::gemm_phase<EpiOutF, pg8::StaticOrder, false>((PG8_LAS unsigned char*)smem, g, S, E, nullptr);
    }
#undef IN
#undef SEAM
}

extern "C" void kernel_launch(void* const* d_in, const int* in_sizes, int n_in, void* d_out, int out_size, void* d_ws, size_t ws_size, hipStream_t stream) {
    static int grid = 0;
    if (grid == 0) {
        int dev = 0, cus = 0, per_cu = 0;
        hipGetDevice(&dev);
        hipDeviceGetAttribute(&cus, hipDeviceAttributeMultiprocessorCount, dev);
        if (hipFuncSetAttribute((const void*)mega_fwd, hipFuncAttributeMaxDynamicSharedMemorySize, LDS_BYTES) != hipSuccess) fprintf(stderr, "kernel_launch: hipFuncSetAttribute failed\n");
        if (hipOccupancyMaxActiveBlocksPerMultiprocessor(&per_cu, (const void*)mega_fwd, NTHR, LDS_BYTES) != hipSuccess || per_cu < 1) { fprintf(stderr, "kernel_launch: occupancy query gave %d\n", per_cu); per_cu = 1; }
        (void)hipGetLastError();
        if (per_cu > 1) per_cu = 1;
        grid = cus * per_cu;
        if (ws_size < WS_END) fprintf(stderr, "kernel_launch: workspace too small: %zu < %zu\n", ws_size, (size_t)WS_END);
    }
    Params p{};
    p.x = (const float*)d_in[0]; p.norm_g = (const float*)d_in[1]; p.w_in = (const float*)d_in[2]; p.conv_w = (const float*)d_in[3]; p.conv_b = (const float*)d_in[4];
    p.w_rg = (const float*)d_in[5]; p.b_rg = (const float*)d_in[6]; p.w_ig = (const float*)d_in[7]; p.b_ig = (const float*)d_in[8]; p.lam = (const float*)d_in[9];
    p.b_merge = (const float*)d_in[10]; p.w_out = (const float*)d_in[11]; p.final_g = (const float*)d_in[12];
    p.out = (float*)d_out; p.ws = (unsigned char*)d_ws;
#if N_LAUNCHES == 1
    p.ph_lo = 0; p.ph_hi = 6;
    if (hipMemsetAsync((unsigned char*)d_ws + WS_BAR, 0, (XCD_BAR_WORDS + 256) * sizeof(unsigned), stream) != hipSuccess) fprintf(stderr, "kernel_launch: memset of the barrier words failed\n");
    void* args[] = {&p};
    hipError_t e = hipLaunchCooperativeKernel((const void*)mega_fwd, dim3(grid), dim3(NTHR), args, LDS_BYTES, stream);
    if (e != hipSuccess) fprintf(stderr, "cooperative launch failed: %s (grid %d)\n", hipGetErrorString(e), grid);
#else
    for (int ph = 0; ph < 6; ++ph) {
        p.ph_lo = ph; p.ph_hi = ph + 1;
        hipLaunchKernelGGL(mega_fwd, dim3(grid), dim3(NTHR), LDS_BYTES, stream, p);
    }
#endif
}
```

```cpp
#include <hip/hip_runtime.h>
#include <hip/hip_cooperative_groups.h>
#include <cstdio>
namespace cg = cooperative_groups;
namespace pg8 {
#define PG8_LAS __attribute__((address_space(3)))
typedef unsigned short bf16_t;
typedef short bf16x8 __attribute__((ext_vector_type(8)));
typedef float f32x4 __attribute__((ext_vector_type(4)));
typedef unsigned u32x4 __attribute__((ext_vector_type(4)));
constexpr int BM = 256, BK = 64, HALF = 128, HTB = HALF * BK * 2  , STAGE_BYTES = 8 * HTB, NXCD = 8, WGM = 8;

__host__ __device__ __forceinline__ int lds_byte(int r, int c) { const int st = (r >> 4) * 2 + (c >> 5), rr = r & 15, cc = c & 31, ob = rr * 64 + cc * 2; return st * 1024 + (ob ^ (((ob >> 9) & 1) << 5)); }
__host__ __device__ __forceinline__ void stage_rc(int b, int& R, int& C) { const int st = b / 1024, sb = b % 1024, swz = sb ^ (((sb >> 9) & 1) << 5); R = (st >> 1) * 16 + swz / 64; C = (st & 1) * 32 + (swz % 64) / 2; }
__host__ __device__ __forceinline__ int perm32(int rho) { const int n = rho >> 4, i = rho & 15; return 8 * (i >> 2) + 4 * n + (i & 3); }

struct Unit { int pm, pn; };
struct Gemm { const bf16_t* A; const bf16_t* Bt; int M, N, K; };

struct StaticOrder {
    int nM, nN, nwg, G, c, rep;
    __host__ __device__ void init(int M, int N, int G_, int c_) { nM = M / BM; nN = N / BM; nwg = nM * nN; G = G_; c = c_; rep = 1; }
    __host__ __device__ bool next(int i, Unit& u) const {
        long L = (long)i * G + c; if (L >= (long)nwg * rep) return false; L %= nwg;
        int wgid = (int)L; { const int q = nwg / NXCD, r = nwg % NXCD, xcd = wgid % NXCD, off = wgid / NXCD; wgid = (xcd < r ? xcd * (q + 1) : r * (q + 1) + (xcd - r) * q) + off; }
        const int nig = WGM * nN, gid = wgid / nig, fm = gid * WGM, gsz = (nM - fm) < WGM ? (nM - fm) : WGM;
        u.pm = fm + ((wgid % nig) % gsz); u.pn = (wgid % nig) / gsz; return true;
    }
    __device__ __forceinline__ void a_ready(const Unit&) const {}
    __device__ __forceinline__ void done(const Unit&) const {}
};
__device__ __forceinline__ unsigned cvt_pk_bf16(float lo, float hi) { unsigned r; asm("v_cvt_pk_bf16_f32 %0, %1, %2" : "=v"(r) : "v"(lo), "v"(hi)); return r; }
template <class Epi, class Sched, bool STAMP = false>
__device__ __forceinline__ void gemm_phase(PG8_LAS unsigned char* lds, const Gemm g, const Sched& S, const Epi& E, unsigned long long* stamps) {
    const int tid = threadIdx.x, wid = __builtin_amdgcn_readfirstlane(tid >> 6), lane = tid & 63, wr = wid >> 2, wc = wid & 3, fr = lane & 15, fq = lane >> 4;
    const int K = g.K, nt = K / BK;
    int ts_lo = 0, ts_hi = 0, nts = 0; const unsigned long long rt_entry = STAMP ? (unsigned long long)wall_clock64() : 0ull;
#define PG8_STAMP() do { if (STAMP && wid == 0 && nts < 64) { const unsigned long long _c = (unsigned long long)clock64(); \
        ts_lo = (lane == nts) ? (int)(unsigned)_c : ts_lo; ts_hi = (lane == nts) ? (int)(unsigned)(_c >> 32) : ts_hi; ++nts; } } while (0)
    PG8_STAMP();
    unsigned voffA[2], voffB[2];
#pragma unroll
    for (int i = 0; i < 2; ++i) { int R, C; stage_rc(tid * 16 + i * 8192, R, C); const int Rb = Epi::PERM ? ((R & ~31) + perm32(R & 31)) : R;
        voffA[i] = (unsigned)(R * K + C) * 2u; voffB[i] = (unsigned)(Rb * K + C) * 2u; }
    const size_t kstep = (size_t)(BK * 2);
    const size_t hstep = (size_t)HALF * K * 2;
    const size_t tstep = 2 * hstep;
    const unsigned ldsw = (unsigned)wid * 1024u;
    const int aoff = lds_byte(wr * 64 + fr, fq * 8), boff = lds_byte(wc * 32 + fr, fq * 8);
#define PG8_SA(b, h) (((b) * 2 + (h)) * HTB)
#define PG8_SB(b, h) ((4 + (b) * 2 + (h)) * HTB)
#define PG8_STAGE(bufoff, gbase, voff) do { _Pragma("unroll") for (int _i = 0; _i < 2; ++_i) \
        __builtin_amdgcn_global_load_lds((const unsigned*)((const char*)(gbase) + (voff)[_i]), (PG8_LAS unsigned*)(lds + (bufoff) + ldsw + _i * 8192), 16, 0, 0); } while (0)
#define PG8_LDA(dst, b, h) do { _Pragma("unroll") for (int m = 0; m < 4; ++m) _Pragma("unroll") for (int k = 0; k < 2; ++k) dst[m][k] = *(const PG8_LAS bf16x8*)(lds + PG8_SA(b, h) + aoff + m * 2048 + k * 1024); } while (0)
#define PG8_LDB(dst, b, h) do { _Pragma("unroll") for (int n = 0; n < 2; ++n) _Pragma("unroll") for (int k = 0; k < 2; ++k) dst[n][k] = *(const PG8_LAS bf16x8*)(lds + PG8_SB(b, h) + boff + n * 2048 + k * 1024); } while (0)
#define PG8_MMA(ai, bj, At, Bt) do { __builtin_amdgcn_s_setprio(1); _Pragma("unroll") for (int m = 0; m < 4; ++m) _Pragma("unroll") for (int n = 0; n < 2; ++n) _Pragma("unroll") for (int k = 0; k < 2; ++k) \
        acc[ai][bj][m][n] = __builtin_amdgcn_mfma_f32_16x16x32_bf16(Bt[n][k], At[m][k], acc[ai][bj][m][n], 0, 0, 0); __builtin_amdgcn_s_setprio(0); } while (0)
#define PG8_WAIT_V(n) asm volatile("s_waitcnt vmcnt(" #n ")" ::: "memory")
#define PG8_WAIT_L(n) asm volatile("s_waitcnt lgkmcnt(" #n ")" ::: "memory")
#define PG8_BAR __builtin_amdgcn_s_barrier()
#define PG8_SCHED __builtin_amdgcn_sched_barrier(0)
    Unit cur, nxt; int ui = 0;
    if (!S.next(0, cur)) return;
    f32x4 acc[2][2][4][2];
#pragma unroll
    for (int a = 0; a < 2; ++a)
#pragma unroll
        for (int b = 0; b < 2; ++b)
#pragma unroll
            for (int m = 0; m < 4; ++m)
#pragma unroll
                for (int n = 0; n < 2; ++n) acc[a][b][m][n] = (f32x4){0.f, 0.f, 0.f, 0.f};
    bf16x8 At[4][2], B0[2][2], B1[2][2];
    const char* cA = (const char*)g.A + (size_t)cur.pm * tstep; const char* cB = (const char*)g.Bt + (size_t)cur.pn * tstep;
    S.a_ready(cur);
    PG8_STAGE(PG8_SB(0, 0), cB, voffB); PG8_STAGE(PG8_SA(0, 0), cA, voffA); PG8_STAGE(PG8_SB(0, 1), cB + hstep, voffB); PG8_STAGE(PG8_SA(0, 1), cA + hstep, voffA);
    if (wr == 1) PG8_BAR;
    PG8_WAIT_V(4); PG8_BAR;
    PG8_STAGE(PG8_SB(1, 0), cB + kstep, voffB); PG8_STAGE(PG8_SA(1, 0), cA + kstep, voffA); PG8_STAGE(PG8_SB(1, 1), cB + hstep + kstep, voffB);
    PG8_WAIT_V(6); PG8_BAR;
    PG8_STAMP();
    for (;;) {
        const bool has_next = S.next(ui + 1, nxt);
        const char* nA = has_next ? (const char*)g.A + (size_t)nxt.pm * tstep : cA; const char* nB = has_next ? (const char*)g.Bt + (size_t)nxt.pn * tstep : cB;
        for (int t = 0; t < nt; t += 2) {
            const bool last = (t == nt - 2);
            const char* a1 = cA + (size_t)(t + 1) * kstep;
            const char* a2 = last ? nA : cA + (size_t)(t + 2) * kstep; const char* b2 = last ? nB : cB + (size_t)(t + 2) * kstep;
            const char* a3 = a2 + kstep; const char* b3 = b2 + kstep;
            if (last && has_next) S.a_ready(nxt);
            PG8_LDB(B0, 0, 0); PG8_SCHED; PG8_LDA(At, 0, 0); PG8_STAGE(PG8_SA(1, 1), a1 + hstep, voffA);
            PG8_WAIT_L(8); PG8_BAR; PG8_WAIT_L(0); PG8_MMA(0, 0, At, B0); PG8_BAR; PG8_SCHED;
            PG8_LDB(B1, 0, 1); PG8_STAGE(PG8_SB(0, 0), b2, voffB);
            PG8_BAR; PG8_WAIT_L(0); PG8_MMA(0, 1, At, B1); PG8_BAR;
            PG8_LDA(At, 0, 1); PG8_STAGE(PG8_SA(0, 0), a2, voffA);
            PG8_BAR; PG8_WAIT_L(0); PG8_MMA(1, 0, At, B0); PG8_BAR; PG8_SCHED;
            PG8_STAGE(PG8_SB(0, 1), b2 + hstep, voffB);
            PG8_WAIT_V(6); PG8_BAR; PG8_MMA(1, 1, At, B1); PG8_BAR;
            PG8_LDB(B0, 1, 0); PG8_SCHED; PG8_LDA(At, 1, 0); PG8_STAGE(PG8_SA(0, 1), a2 + hstep, voffA);
            PG8_WAIT_L(8); PG8_BAR; PG8_WAIT_L(0); PG8_MMA(0, 0, At, B0); PG8_BAR; PG8_SCHED;
            PG8_LDB(B1, 1, 1); PG8_STAGE(PG8_SB(1, 0), b3, voffB);
            PG8_BAR; PG8_WAIT_L(0); PG8_MMA(0, 1, At, B1); PG8_BAR;
            PG8_LDA(At, 1, 1); PG8_STAGE(PG8_SA(1, 0), a3, voffA);
            PG8_BAR; PG8_WAIT_L(0); PG8_MMA(1, 0, At, B0); PG8_BAR; PG8_SCHED;
            PG8_STAGE(PG8_SB(1, 1), b3 + hstep, voffB);
            PG8_WAIT_V(6); PG8_BAR; PG8_MMA(1, 1, At, B1); PG8_BAR;
        }
        PG8_STAMP();
        if (!Epi::AFTER_DRAIN || has_next) { E(acc, cur, wr, wc, fr, fq); S.done(cur); }
        PG8_STAMP();
        if (!has_next) break;
#pragma unroll
        for (int a = 0; a < 2; ++a)
#pragma unroll
            for (int b = 0; b < 2; ++b)
#pragma unroll
                for (int m = 0; m < 4; ++m)
#pragma unroll
                    for (int n = 0; n < 2; ++n) acc[a][b][m][n] = (f32x4){0.f, 0.f, 0.f, 0.f};
        cur = nxt; cA = nA; cB = nB; ++ui;
    }
    PG8_WAIT_V(0);
    if (wr == 0) PG8_BAR;
    PG8_BAR;
    if constexpr (Epi::AFTER_DRAIN) { E.fused(acc, cur, wr, wc, fr, fq, lds, wid, lane); S.done(cur); }
    PG8_STAMP();
    if (STAMP && wid == 0) { stamps[lane] = lane < nts ? (((unsigned long long)(unsigned)ts_hi << 32) | (unsigned)ts_lo) : 0ull;
        if (lane == 62) stamps[62] = rt_entry; if (lane == 63) stamps[63] = (unsigned long long)wall_clock64(); }
#undef PG8_STAMP
#undef PG8_SA
#undef PG8_SB
#undef PG8_STAGE
#undef PG8_LDA
#undef PG8_LDB
#undef PG8_MMA
#undef PG8_WAIT_V
#undef PG8_WAIT_L
#undef PG8_BAR
#undef PG8_SCHED
}
}

typedef unsigned short u16;
typedef short bf16x8 __attribute__((ext_vector_type(8)));
typedef short s16x4 __attribute__((ext_vector_type(4)));
typedef float f32x4 __attribute__((ext_vector_type(4)));
typedef float f32x16 __attribute__((ext_vector_type(16)));
typedef unsigned u32x4 __attribute__((ext_vector_type(4)));
typedef unsigned u32x2 __attribute__((ext_vector_type(2)));

constexpr int S_ = 16384, DM = 2048, NIN = 16384, DCAT = 4096;
constexpr int NTHR = 512;
constexpr int LDS_BYTES = 131072;
constexpr size_t MiB = (size_t)1 << 20;
constexpr size_t WS_LX = 0;
constexpr size_t WS_Q = 64 * MiB;
constexpr size_t WS_K = 128 * MiB;
constexpr size_t WS_V = 192 * MiB;
constexpr size_t WS_G = 256 * MiB;
constexpr size_t WS_WOUT = 384 * MiB;
constexpr size_t WS_WRG = 400 * MiB;
constexpr size_t WS_WIG = 400 * MiB + 512 * 1024;
constexpr size_t WS_AGG = 401 * MiB;
constexpr size_t WS_ROWSS = 402 * MiB;
constexpr size_t WS_BAR = 404 * MiB;
constexpr size_t WS_END = 405 * MiB;
constexpr int LRU_FLAG0 = 3456;
constexpr float LOG2E = 1.4426950408889634f, LN2 = 0.6931471805599453f;
constexpr float QSCALE = 0.08838834764831845f * 1.4426950408889634f;

struct Params {
    const float *x, *norm_g, *w_in, *conv_w, *conv_b, *w_rg, *b_rg, *w_ig, *b_ig, *lam, *b_merge, *w_out, *final_g;
    float* out; unsigned char* ws; int ph_lo, ph_hi;
};

#define DI __device__ __forceinline__
DI float bf2f(u16 b) { return __uint_as_float(((unsigned)b) << 16); }
DI float fexp2(float x) { return __builtin_amdgcn_exp2f(x); }
DI float flog2(float x) { return __builtin_amdgcn_logf(x); }
DI float frcp(float x) { return __builtin_amdgcn_rcpf(x); }
DI float wave_sum(float v) { v += __shfl_xor(v, 32); v += __shfl_xor(v, 16); v += __shfl_xor(v, 8); v += __shfl_xor(v, 4); v += __shfl_xor(v, 2); v += __shfl_xor(v, 1); return v; }
#define MFMA32(a, b, c) __builtin_amdgcn_mfma_f32_32x32x16_bf16((a), (b), (c), 0, 0, 0)
DI int crow(int reg, int h) { return (reg & 3) + 8 * (reg >> 2) + 4 * h; }

DI int mapcol(int n) {
    const int seg = n >> 11, c = n & 2047, pr = (c >> 7) * 256 + (c & 127);
    switch (seg) {
        case 0: return c;
        case 1: return 2048 + pr;
        case 2: return 6144 + c;
        case 3: return 8192 + c;
        case 4: return 10240 + c;
        case 5: return 12288 + pr;
        case 6: return 2048 + pr + 128;
        default: return 12288 + pr + 128;
    }
}
DI void tr_tile(const float* src, size_t sp, u16* dst, size_t dp, float* t, float scale) {
    const int tid = threadIdx.x;
#pragma unroll
    for (int ps = 0; ps < 2; ++ps) {
        const int r = ps * 32 + (tid >> 4), c4 = (tid & 15) * 4;
        const f32x4 v = *(const f32x4*)(src + (size_t)r * sp + c4);
        t[r * 65 + c4] = v[0]; t[r * 65 + c4 + 1] = v[1]; t[r * 65 + c4 + 2] = v[2]; t[r * 65 + c4 + 3] = v[3];
    }
    __syncthreads();
    const int c = tid >> 3, r8 = (tid & 7) * 8;
    u32x4 w;
    w[0] = pg8::cvt_pk_bf16(t[(r8 + 0) * 65 + c] * scale, t[(r8 + 1) * 65 + c] * scale);
    w[1] = pg8::cvt_pk_bf16(t[(r8 + 2) * 65 + c] * scale, t[(r8 + 3) * 65 + c] * scale);
    w[2] = pg8::cvt_pk_bf16(t[(r8 + 4) * 65 + c] * scale, t[(r8 + 5) * 65 + c] * scale);
    w[3] = pg8::cvt_pk_bf16(t[(r8 + 6) * 65 + c] * scale, t[(r8 + 7) * 65 + c] * scale);
    *(u32x4*)(dst + (size_t)c * dp + r8) = w;
    __syncthreads();
}

template <bool MAPN>
DI void tr_tile256(const float* src, size_t sp, u16* dst, size_t dp, int n0, float* t) {
    const int tid = threadIdx.x;
    f32x4 v[8];
#pragma unroll
    for (int i = 0; i < 8; ++i) v[i] = __builtin_nontemporal_load((const f32x4*)(src + (size_t)(i * 8 + (tid >> 6)) * sp + (tid & 63) * 4));
#pragma unroll
    for (int i = 0; i < 8; ++i) {
        float* q = t + (i * 8 + (tid >> 6)) * 257 + (tid & 63) * 4;
        q[0] = v[i][0]; q[1] = v[i][1]; q[2] = v[i][2]; q[3] = v[i][3];
    }
    __syncthreads();
    const int n = tid >> 1, kh = (tid & 1) * 32;
    const int nd = MAPN ? mapcol(n0 + n) : (n0 + n);
    u16* drow = dst + (size_t)nd * dp + kh;
    float f[32];
#pragma unroll
    for (int i = 0; i < 32; ++i) f[i] = t[(kh + i) * 257 + n];
#pragma unroll
    for (int c = 0; c < 4; ++c) {
        u32x4 w;
        w[0] = pg8::cvt_pk_bf16(f[8 * c], f[8 * c + 1]); w[1] = pg8::cvt_pk_bf16(f[8 * c + 2], f[8 * c + 3]);
        w[2] = pg8::cvt_pk_bf16(f[8 * c + 4], f[8 * c + 5]); w[3] = pg8::cvt_pk_bf16(f[8 * c + 6], f[8 * c + 7]);
        *(u32x4*)(drow + c * 8) = w;
    }
    __syncthreads();
}

DI void p0_prep(const Params& p, unsigned char* smem) {
    const int tid = threadIdx.x, lane = tid & 63, wave = tid >> 6;
    u16* HB = (u16*)p.out;
    u16* WINT = (u16*)((unsigned char*)p.out + 64 * MiB);
    u16* WOUT = (u16*)(p.ws + WS_WOUT);
    u16* WRG = (u16*)(p.ws + WS_WRG);
    u16* WIG = (u16*)(p.ws + WS_WIG);
    f32x4 gn[8];
#pragma unroll
    for (int i = 0; i < 8; ++i) gn[i] = ((const f32x4*)p.norm_g)[i * 64 + lane];
    for (int row = blockIdx.x * 8 + wave; row < S_; row += 2 * gridDim.x * 8) {
        const int row2 = row + gridDim.x * 8;
        const bool has2 = row2 < S_;
        const f32x4* xr = (const f32x4*)(p.x + (size_t)row * DM);
        const f32x4* xr2 = (const f32x4*)(p.x + (size_t)(has2 ? row2 : row) * DM);
        f32x4 v[8], w[8]; float ss = 0.f, ss2 = 0.f;
#pragma unroll
        for (int i = 0; i < 8; ++i) v[i] = __builtin_nontemporal_load(xr + i * 64 + lane);
#pragma unroll
        for (int i = 0; i < 8; ++i) w[i] = __builtin_nontemporal_load(xr2 + i * 64 + lane);
#pragma unroll
        for (int i = 0; i < 8; ++i) { ss += v[i][0] * v[i][0] + v[i][1] * v[i][1] + v[i][2] * v[i][2] + v[i][3] * v[i][3]; ss2 += w[i][0] * w[i][0] + w[i][1] * w[i][1] + w[i][2] * w[i][2] + w[i][3] * w[i][3]; }
        ss = wave_sum(ss); ss2 = wave_sum(ss2);
        const float rstd = rsqrtf(ss * (1.0f / DM) + 1e-6f), rstd2 = rsqrtf(ss2 * (1.0f / DM) + 1e-6f);
#pragma unroll
        for (int i = 0; i < 8; ++i) {
            const f32x4 g = gn[i];
            u32x2 o; o[0] = pg8::cvt_pk_bf16(v[i][0] * rstd * g[0], v[i][1] * rstd * g[1]); o[1] = pg8::cvt_pk_bf16(v[i][2] * rstd * g[2], v[i][3] * rstd * g[3]);
            *(u32x2*)(HB + (size_t)row * DM + (i * 64 + lane) * 4) = o;
        }
        if (has2) {
#pragma unroll
            for (int i = 0; i < 8; ++i) {
                const f32x4 g = gn[i];
                u32x2 o; o[0] = pg8::cvt_pk_bf16(w[i][0] * rstd2 * g[0], w[i][1] * rstd2 * g[1]); o[1] = pg8::cvt_pk_bf16(w[i][2] * rstd2 * g[2], w[i][3] * rstd2 * g[3]);
                *(u32x2*)(HB + (size_t)row2 * DM + (i * 64 + lane) * 4) = o;
            }
        }
    }
    float* t = (float*)smem;
    constexpr int T_WIN = 32 * 64, T_WOUT = 64 * 8, T_G = 64;
    for (int ti = blockIdx.x; ti < T_WIN + T_WOUT + 2 * T_G; ti += gridDim.x) {
        if (ti < T_WIN) {
            const int tk = ti & 31, tn = ti >> 5;
            tr_tile256<true>(p.w_in + (size_t)(tk * 64) * NIN + tn * 256, NIN, WINT + tk * 64, DM, tn * 256, t);
        } else if (ti < T_WIN + T_WOUT) {
            const int u = ti - T_WIN, tc = u & 63, td = u >> 6;
            tr_tile256<false>(p.w_out + (size_t)(tc * 64) * DM + td * 256, DM, WOUT + tc * 64, DCAT, td * 256, t);
        } else {
            int u = ti - T_WIN - T_WOUT; const float* src = p.w_rg; u16* dst = WRG;
            if (u >= T_G) { u -= T_G; src = p.w_ig; dst = WIG; }
            const int b = u >> 2, ti2 = (u >> 1) & 1, tj = u & 1;
            tr_tile(src + (size_t)b * 16384 + (ti2 * 64) * 128 + tj * 64, 128, dst + (size_t)b * 16384 + (tj * 64) * 128 + ti2 * 64, 128, t, -LOG2E);
        }
    }
}

struct EpiProj {
    static constexpr bool PERM = true, AFTER_DRAIN = false;
    u16 *LX, *Q, *K, *V, *G; const float* bm;
    DI void operator()(const f32x4 (&acc)[2][2][4][2], const pg8::Unit& u, int wr, int wc, int fr, int fq) const {
        const int pn = u.pn, row0 = u.pm * 256 + wr * 64 + fr, cl = wc * 32 + 8 * fq;
        if ((pn >= 8 && pn < 24) || pn >= 48) {
            const int gbase = (pn >= 48 ? 2048 + (pn - 48) * 128 : (pn - 8) * 128) + cl;
            const f32x4 b0 = *(const f32x4*)(bm + gbase), b1 = *(const f32x4*)(bm + gbase + 4);
#pragma unroll
            for (int ai = 0; ai < 2; ++ai)
#pragma unroll
                for (int m = 0; m < 4; ++m) {
                    const f32x4 g0 = acc[ai][0][m][0], g1 = acc[ai][0][m][1];
                    const f32x4 m0 = acc[ai][1][m][0] + b0, m1 = acc[ai][1][m][1] + b1;
                    float o[8];
#pragma unroll
                    for (int e = 0; e < 4; ++e) {
                        o[e] = g0[e] * frcp((1.0f + fexp2(-g0[e] * LOG2E)) * (1.0f + fexp2(-m0[e] * LOG2E)));
                        o[4 + e] = g1[e] * frcp((1.0f + fexp2(-g1[e] * LOG2E)) * (1.0f + fexp2(-m1[e] * LOG2E)));
                    }
                    u32x4 w; w[0] = pg8::cvt_pk_bf16(o[0], o[1]); w[1] = pg8::cvt_pk_bf16(o[2], o[3]); w[2] = pg8::cvt_pk_bf16(o[4], o[5]); w[3] = pg8::cvt_pk_bf16(o[6], o[7]);
                    *(u32x4*)(G + (size_t)(row0 + ai * 128 + m * 16) * DCAT + gbase) = w;
                }
        } else {
            u16* base; int colt; float sc = 1.0f;
            if (pn < 8) { base = LX; colt = pn * 256; }
            else if (pn < 32) { base = Q; colt = (pn - 24) * 256; sc = QSCALE; }
            else if (pn < 40) { base = K; colt = (pn - 32) * 256; }
            else { base = V; colt = (pn - 40) * 256; }
#pragma unroll
            for (int ai = 0; ai < 2; ++ai)
#pragma unroll
                for (int m = 0; m < 4; ++m)
#pragma unroll
                    for (int bj = 0; bj < 2; ++bj) {
                        const f32x4 v0 = acc[ai][bj][m][0] * sc, v1 = acc[ai][bj][m][1] * sc;
                        u32x4 w; w[0] = pg8::cvt_pk_bf16(v0[0], v0[1]); w[1] = pg8::cvt_pk_bf16(v0[2], v0[3]); w[2] = pg8::cvt_pk_bf16(v1[0], v1[1]); w[3] = pg8::cvt_pk_bf16(v1[2], v1[3]);
                        *(u32x4*)(base + (size_t)(row0 + ai * 128 + m * 16) * DM + colt + bj * 128 + cl) = w;
                    }
        }
    }
};

struct EpiOut {
    static constexpr bool PERM = false, AFTER_DRAIN = false;
    const float* x; float* out; float* rowss;
    DI void operator()(const f32x4 (&acc)[2][2][4][2], const pg8::Unit& u, int wr, int wc, int fr, int fq) const {
        const int row0 = u.pm * 256 + wr * 64 + fr, col0 = u.pn * 256 + wc * 32 + 4 * fq;
#pragma unroll
        for (int ai = 0; ai < 2; ++ai)
#pragma unroll
            for (int m = 0; m < 4; ++m) {
                const int row = row0 + ai * 128 + m * 16; float ss = 0.f;
#pragma unroll
                for (int bj = 0; bj < 2; ++bj)
#pragma unroll
                    for (int n = 0; n < 2; ++n) {
                        const size_t off = (size_t)row * DM + col0 + bj * 128 + n * 16;
                        const f32x4 v = *(const f32x4*)(x + off) + acc[ai][bj][m][n];
                        *(f32x4*)(out + off) = v;
                        ss += v[0] * v[0] + v[1] * v[1] + v[2] * v[2] + v[3] * v[3];
                    }
                ss += __shfl_xor(ss, 16); ss += __shfl_xor(ss, 32);
                if (fq == 0) rowss[(size_t)row * 32 + u.pn * 4 + wc] = ss;
            }
    }
};

constexpr int LRU_XCB = 0, LRU_XCF = 17408, LRU_AB = 17408 + 32768, LRU_PARTS = 17408 + 65536;
template <bool FINAL>
DI void lru_unit(const Params& p, unsigned char* smem, int chunk, int blk, u16* Gdst) {
    const int tid = threadIdx.x, lane = tid & 63, wave = tid >> 6;
    const u16* LX = (const u16*)(p.ws + WS_LX);
    const u16* G = (const u16*)(p.ws + WS_G);
    float* AGG = (float*)(p.ws + WS_AGG);
    u16* xcb = (u16*)(smem + LRU_XCB);
    float* xcf = (float*)(smem + LRU_XCF);
    float* hbuf = (float*)(smem + LRU_AB);
    float* gp = (float*)(smem + LRU_PARTS);
    const int th = wave >> 2, cq = wave & 3, rr = lane & 31, h = lane >> 5, j = cq * 32 + rr, ch = blk * 128 + j;
    bf16x8 wrg[8], wig[8];
    {
        const u16* WRG = (const u16*)(p.ws + WS_WRG) + (size_t)blk * 16384 + j * 128 + 8 * h;
        const u16* WIG = (const u16*)(p.ws + WS_WIG) + (size_t)blk * 16384 + j * 128 + 8 * h;
#pragma unroll
        for (int ks = 0; ks < 8; ++ks) { wrg[ks] = *(const bf16x8*)(WRG + ks * 16); wig[ks] = *(const bf16x8*)(WIG + ks * 16); }
    }
    const float brg = -p.b_rg[ch] * LOG2E, big = -p.b_ig[ch] * LOG2E;
    const float c2 = -8.0f * log1pf(expf(-p.lam[ch])) * LOG2E;
    const int cc = (tid & 63) * 2, tg = tid >> 6, cch = blk * 128 + cc;
    float cw[4][2], cb[2];
#pragma unroll
    for (int tap = 0; tap < 4; ++tap) { cw[tap][0] = p.conv_w[tap * DM + cch]; cw[tap][1] = p.conv_w[tap * DM + cch + 1]; }
    cb[0] = p.conv_b[cch]; cb[1] = p.conv_b[cch + 1];
    const int etok = tid >> 4, ech8 = (tid & 15) * 8;
    float h_run = 0.f, a_run = 1.f;
    if (FINAL) {
        if (wave == 0 && lane < chunk) {
            const unsigned* fl = (const unsigned*)(p.ws + WS_BAR) + LRU_FLAG0 + lane * 16 + blk;
            unsigned sp = 0;
            while (__hip_atomic_load(fl, __ATOMIC_RELAXED, __HIP_MEMORY_SCOPE_AGENT) == 0u && ++sp < (1u << 22)) __builtin_amdgcn_s_sleep(2);
        }
        __syncthreads();
        float An[15], Bn[15];
#pragma unroll
        for (int n = 0; n < 15; ++n) {
            An[n] = 1.f; Bn[n] = 0.f;
            if (n < chunk) {
                An[n] = __uint_as_float(__hip_atomic_load((const unsigned*)AGG + (size_t)(n * 2) * DM + ch, __ATOMIC_RELAXED, __HIP_MEMORY_SCOPE_AGENT));
                Bn[n] = __uint_as_float(__hip_atomic_load((const unsigned*)AGG + (size_t)(n * 2 + 1) * DM + ch, __ATOMIC_RELAXED, __HIP_MEMORY_SCOPE_AGENT));
            }
        }
#pragma unroll
        for (int n = 0; n < 15; ++n) h_run = An[n] * h_run + Bn[n];
    }
    unsigned lxn[11];
#define LRU_LXLOAD(T0) do { _Pragma("unroll") for (int r_ = 0; r_ < 11; ++r_) { const int tok_ = (T0) + tg * 8 - 3 + r_; \
        lxn[r_] = (tok_ >= 0) ? *(const unsigned*)(LX + (size_t)tok_ * DM + cch) : 0u; } } while (0)
    LRU_LXLOAD(chunk * 1024);
    for (int st = 0; st < 16; ++st) {
        const int t0 = chunk * 1024 + st * 64;
        float xv[11][2];
#pragma unroll
        for (int r = 0; r < 11; ++r) { xv[r][0] = __uint_as_float(lxn[r] << 16); xv[r][1] = __uint_as_float(lxn[r] & 0xffff0000u); }
        if (st < 15) LRU_LXLOAD(t0 + 64);
        u32x4 gq[2];
        if (FINAL) {
#pragma unroll
            for (int k = 0; k < 2; ++k) gq[k] = *(const u32x4*)(G + (size_t)(t0 + k * 32 + etok) * DCAT + blk * 128 + ech8);
        }
#pragma unroll
        for (int q = 0; q < 8; ++q) {
            float y0 = cb[0], y1 = cb[1];
#pragma unroll
            for (int tap = 0; tap < 4; ++tap) { y0 += xv[q + tap][0] * cw[tap][0]; y1 += xv[q + tap][1] * cw[tap][1]; }
            const int tok = tg * 8 + q;
            *(unsigned*)(xcb + tok * 136 + cc) = pg8::cvt_pk_bf16(y0, y1);
            xcf[tok * 128 + cc] = y0; xcf[tok * 128 + cc + 1] = y1;
        }
        __syncthreads();
        float av[16], uv[16];
        {
            f32x16 ar, ai;
#pragma unroll
            for (int i = 0; i < 16; ++i) { ar[i] = brg; ai[i] = big; }
            bf16x8 af[8];
#pragma unroll
            for (int ks = 0; ks < 8; ++ks) af[ks] = *(const bf16x8*)(xcb + (th * 32 + rr) * 136 + ks * 16 + 8 * h);
            float xq[16];
#pragma unroll
            for (int i = 0; i < 16; ++i) xq[i] = xcf[(th * 32 + crow(i, h)) * 128 + j];
#pragma unroll
            for (int ks = 0; ks < 8; ++ks) { ar = MFMA32(af[ks], wrg[ks], ar); ai = MFMA32(af[ks], wig[ks], ai); }
#pragma unroll
            for (int i = 0; i < 16; ++i) {
                const float xvv = xq[i];
                const float e1 = fexp2(ar[i]), e2 = fexp2(ai[i]);
                const float r = frcp(1.0f + e1), ig = frcp(1.0f + e2);
                const float a = fexp2(r * c2);
                av[i] = a;
                uv[i] = __builtin_amdgcn_sqrtf(fmaf(-a, a, 1.0f)) * (ig * xvv);
            }
#pragma unroll
            for (int g = 0; g < 4; ++g) {
                float A = av[4 * g], B = uv[4 * g];
#pragma unroll
                for (int e2 = 1; e2 < 4; ++e2) { B = av[4 * g + e2] * B + uv[4 * g + e2]; A *= av[4 * g + e2]; }
                gp[(th * 8 + 2 * g + h) * 128 + j] = A; gp[2048 + (th * 8 + 2 * g + h) * 128 + j] = B;
            }
        }
        __syncthreads();
        {
            float hin[4] = {0.f, 0.f, 0.f, 0.f};
            float hr = h_run;
#pragma unroll
            for (int t2 = 0; t2 < 2; ++t2)
#pragma unroll
                for (int g2 = 0; g2 < 4; ++g2)
#pragma unroll
                    for (int h2 = 0; h2 < 2; ++h2) {
                        const int Gi = t2 * 8 + 2 * g2 + h2;
                        hin[g2] = (t2 == th && h2 == h) ? hr : hin[g2];
                        const float A = gp[Gi * 128 + j], B = gp[2048 + Gi * 128 + j];
                        hr = A * hr + B; a_run *= A;
                    }
            h_run = hr;
            if (FINAL) {
#pragma unroll
                for (int g = 0; g < 4; ++g) {
                    float hh = hin[g];
#pragma unroll
                    for (int e2 = 0; e2 < 4; ++e2) { hh = av[4 * g + e2] * hh + uv[4 * g + e2]; hbuf[(th * 32 + 8 * g + 4 * h + e2) * 128 + j] = hh; }
                }
            }
        }
        if (FINAL) {
            __syncthreads();
#pragma unroll
            for (int k = 0; k < 2; ++k) {
                const f32x4 h0 = *(const f32x4*)(hbuf + (k * 32 + etok) * 128 + ech8), h1 = *(const f32x4*)(hbuf + (k * 32 + etok) * 128 + ech8 + 4);
                u32x4 w;
                w[0] = pg8::cvt_pk_bf16(h0[0] * __uint_as_float(gq[k][0] << 16), h0[1] * __uint_as_float(gq[k][0] & 0xffff0000u));
                w[1] = pg8::cvt_pk_bf16(h0[2] * __uint_as_float(gq[k][1] << 16), h0[3] * __uint_as_float(gq[k][1] & 0xffff0000u));
                w[2] = pg8::cvt_pk_bf16(h1[0] * __uint_as_float(gq[k][2] << 16), h1[1] * __uint_as_float(gq[k][2] & 0xffff0000u));
                w[3] = pg8::cvt_pk_bf16(h1[2] * __uint_as_float(gq[k][3] << 16), h1[3] * __uint_as_float(gq[k][3] & 0xffff0000u));
                *(u32x4*)(Gdst + (size_t)(t0 + k * 32 + etok) * DCAT + blk * 128 + ech8) = w;
            }
        }
    }
#undef LRU_LXLOAD
    __syncthreads();
    if (!FINAL) {
        if (wave < 4 && h == 0) {
            __hip_atomic_store((unsigned*)AGG + (size_t)(chunk * 2) * DM + ch, __float_as_uint(a_run), __ATOMIC_RELAXED, __HIP_MEMORY_SCOPE_AGENT);
            __hip_atomic_store((unsigned*)AGG + (size_t)(chunk * 2 + 1) * DM + ch, __float_as_uint(h_run), __ATOMIC_RELAXED, __HIP_MEMORY_SCOPE_AGENT);
        }
        asm volatile("s_waitcnt vmcnt(0)" ::: "memory");
        __syncthreads();
        if (tid == 0) __hip_atomic_store((unsigned*)(p.ws + WS_BAR) + LRU_FLAG0 + chunk * 16 + blk, 1u, __ATOMIC_RELAXED, __HIP_MEMORY_SCOPE_AGENT);
    }
}

constexpr int ATT_K = 0, ATT_V = 17408;
typedef __attribute__((address_space(3))) s16x4 lds_s16x4;
template <bool MASK>
DI void sb_weights(const f32x16& z, int kb, int query, int h, float& rem, float (&pw)[16]) {
    float be[16], om[16];
#pragma unroll
    for (int i = 0; i < 16; ++i) {
        const float b = frcp(1.0f + fexp2(-z[i]));
        if (MASK) { const bool valid = (kb + crow(i, h)) < query; be[i] = valid ? b : 0.f; om[i] = valid ? 1.0f - b : 1.0f; }
        else { be[i] = b; om[i] = 1.0f - b; }
    }
    float T[4], To[4], ex[16];
#pragma unroll
    for (int g = 0; g < 4; ++g) {
        ex[4 * g + 3] = 1.0f; ex[4 * g + 2] = om[4 * g + 3]; ex[4 * g + 1] = ex[4 * g + 2] * om[4 * g + 2]; ex[4 * g] = ex[4 * g + 1] * om[4 * g + 1];
        T[g] = ex[4 * g] * om[4 * g];
        To[g] = __shfl_xor(T[g], 32);
    }
    float Sg[4]; float suf = rem;
#pragma unroll
    for (int g = 3; g >= 0; --g) { Sg[g] = (h == 0) ? suf * To[g] : suf; suf *= T[g] * To[g]; }
#pragma unroll
    for (int i = 0; i < 16; ++i) pw[i] = be[i] * (Sg[i >> 2] * ex[i]);
    rem = suf;
}
DI bf16x8 pack8(const float* v) {
    u32x4 w; w[0] = pg8::cvt_pk_bf16(v[0], v[1]); w[1] = pg8::cvt_pk_bf16(v[2], v[3]); w[2] = pg8::cvt_pk_bf16(v[4], v[5]); w[3] = pg8::cvt_pk_bf16(v[6], v[7]);
    return __builtin_bit_cast(bf16x8, w);
}
DI void attn_unit(const Params& p, unsigned char* smem, int hd, int qb, u16* Gdst) {
    const int tid = threadIdx.x, lane = tid & 63, wave = tid >> 6;
    const u16* Qg = (const u16*)(p.ws + WS_Q);
    const u16* Kg = (const u16*)(p.ws + WS_K);
    const u16* Vg = (const u16*)(p.ws + WS_V);
    const u16* G = (const u16*)(p.ws + WS_G);
    u16* Kt = (u16*)(smem + ATT_K);
    u16* Vt = (u16*)(smem + ATT_V);
    unsigned* aflags = (unsigned*)(smem + 8 * 8704);
    const int rr = lane & 31, h = lane >> 5, qw = qb * 256 + wave * 32, query = qw + rr;
    const int i16 = lane & 15, q4 = i16 >> 2, p4 = i16 & 3, blk = (lane >> 4) & 1;
    bf16x8 qf[8];
    {
        const u16* qp = Qg + (size_t)query * DM + hd * 128 + 8 * h;
#pragma unroll
        for (int ks = 0; ks < 8; ++ks) qf[ks] = *(const bf16x8*)(qp + ks * 16);
    }
    f32x16 o[4];
#pragma unroll
    for (int d = 0; d < 4; ++d)
#pragma unroll
        for (int i = 0; i < 16; ++i) o[d][i] = 0.f;
    float rem = 1.0f; bool done = false;
    const int lk0 = tid >> 4, lp = tid & 15;
    u32x4 kr[2], vr[2];
    const int kt_hi = qb * 4 + 3;
    const u16* kp = Kt + rr * 136 + 8 * h;
    const u16* vp = Vt + (4 * h + q4) * 136 + 16 * blk + 4 * p4;
#define ATT_LOAD(kt) do { _Pragma("unroll") for (int i_ = 0; i_ < 2; ++i_) { const size_t g_ = (size_t)((kt) * 64 + lk0 + i_ * 32) * DM + hd * 128 + lp * 8; \
        kr[i_] = *(const u32x4*)(Kg + g_); vr[i_] = *(const u32x4*)(Vg + g_); } } while (0)
    ATT_LOAD(kt_hi);
    for (int kt = kt_hi; kt >= 0; --kt) {
#pragma unroll
        for (int i = 0; i < 2; ++i) { *(u32x4*)(Kt + (lk0 + i * 32) * 136 + lp * 8) = kr[i]; *(u32x4*)(Vt + (lk0 + i * 32) * 136 + lp * 8) = vr[i]; }
        __syncthreads();
        if (kt > 0) ATT_LOAD(kt - 1);
        if (!done && kt * 64 <= qw) {
            f32x16 z0, z1;
#pragma unroll
            for (int i = 0; i < 16; ++i) { z0[i] = 0.f; z1[i] = 0.f; }
#pragma unroll
            for (int ks = 0; ks < 8; ++ks) {
                const bf16x8 a0 = *(const bf16x8*)(kp + ks * 16), a1 = *(const bf16x8*)(kp + 32 * 136 + ks * 16);
                z0 = MFMA32(a0, qf[ks], z0); z1 = MFMA32(a1, qf[ks], z1);
            }
            bf16x8 pf[4];
            if (kt * 64 + 63 >= qw) {
                { float pw[16]; sb_weights<true>(z1, kt * 64 + 32, query, h, rem, pw); pf[2] = pack8(pw); pf[3] = pack8(pw + 8); }
                __builtin_amdgcn_sched_barrier(0);
                { float pw[16]; sb_weights<true>(z0, kt * 64, query, h, rem, pw); pf[0] = pack8(pw); pf[1] = pack8(pw + 8); }
            } else {
                { float pw[16]; sb_weights<false>(z1, kt * 64 + 32, query, h, rem, pw); pf[2] = pack8(pw); pf[3] = pack8(pw + 8); }
                __builtin_amdgcn_sched_barrier(0);
                { float pw[16]; sb_weights<false>(z0, kt * 64, query, h, rem, pw); pf[0] = pack8(pw); pf[1] = pack8(pw + 8); }
            }
            __builtin_amdgcn_sched_barrier(0);
            bf16x8 vf[2][4];
#define ATT_VLD(s_, buf_) do { _Pragma("unroll") for (int d_ = 0; d_ < 4; ++d_) { \
                    const s16x4 lo_ = __builtin_amdgcn_ds_read_tr16_b64_v4i16((lds_s16x4*)(vp + (16 * (s_)) * 136 + d_ * 32)); \
                    const s16x4 hi_ = __builtin_amdgcn_ds_read_tr16_b64_v4i16((lds_s16x4*)(vp + (16 * (s_) + 8) * 136 + d_ * 32)); \
                    vf[buf_][d_] = __builtin_shufflevector(lo_, hi_, 0, 1, 2, 3, 4, 5, 6, 7); } } while (0)
            ATT_VLD(0, 0);
            __builtin_amdgcn_sched_barrier(0);
#pragma unroll
            for (int s = 0; s < 4; ++s) {
                if (s + 1 < 4) { if ((s + 1) & 1) ATT_VLD(s + 1, 1); else ATT_VLD(s + 1, 0); }
                __builtin_amdgcn_sched_barrier(0);
#pragma unroll
                for (int d = 0; d < 4; ++d) o[d] = MFMA32(vf[s & 1][d], pf[s], o[d]);
                __builtin_amdgcn_sched_barrier(0);
            }
#undef ATT_VLD
            done = (__ballot(rem != 0.0f) == 0ull);
        }
        if (lane == 0) aflags[wave] = done ? 1u : 0u;
        __syncthreads();
        {
            const u32x4 f0 = *(const u32x4*)aflags, f1 = *(const u32x4*)(aflags + 4);
            if ((f0[0] & f0[1] & f0[2] & f0[3] & f1[0] & f1[1] & f1[2] & f1[3]) != 0u) break;
        }
    }
#undef ATT_LOAD
    {
        const int er = lane >> 4, ep = lane & 15;
        u32x4 gv[8];
#pragma unroll
        for (int i = 0; i < 8; ++i) gv[i] = *(const u32x4*)(G + (size_t)(qw + i * 4 + er) * DCAT + 2048 + hd * 128 + ep * 8);
        unsigned char* ot = smem + wave * 8704;
#pragma unroll
        for (int d = 0; d < 4; ++d)
#pragma unroll
            for (int g = 0; g < 4; ++g) {
                u32x2 w; w[0] = pg8::cvt_pk_bf16(o[d][4 * g], o[d][4 * g + 1]); w[1] = pg8::cvt_pk_bf16(o[d][4 * g + 2], o[d][4 * g + 3]);
                *(u32x2*)(ot + rr * 272 + (d * 32 + 8 * g + 4 * h) * 2) = w;
            }
#pragma unroll
        for (int i = 0; i < 8; ++i) {
            const u32x4 ov = *(const u32x4*)(ot + (i * 4 + er) * 272 + ep * 16);
            u32x4 w;
#pragma unroll
            for (int e = 0; e < 4; ++e)
                w[e] = pg8::cvt_pk_bf16(__uint_as_float(ov[e] << 16) * __uint_as_float(gv[i][e] << 16), __uint_as_float(ov[e] & 0xffff0000u) * __uint_as_float(gv[i][e] & 0xffff0000u));
            *(u32x4*)(Gdst + (size_t)(qw + i * 4 + er) * DCAT + 2048 + hd * 128 + ep * 8) = w;
        }
    }
    __syncthreads();
}


#include <vector>

#define XB_TMO      128
#define XB_XCNT(j)  (256  + 64 * (j))
#define XB_XSUB(j)  (1280 + 64 * (j))
#define XB_XGEN(j)  (2304 + 64 * (j))
#define XB_TOP      3328
#define XB_TOPGEN   3392
#define XCD_BAR_WORDS 3456
#define XB_SPIN_CAP (1u << 18)
#define LAS __attribute__((address_space(3)))

__device__ __forceinline__ unsigned xb_ld(unsigned* p)              { return __hip_atomic_load(p, __ATOMIC_RELAXED, __HIP_MEMORY_SCOPE_AGENT); }
__device__ __forceinline__ unsigned xb_add(unsigned* p, unsigned v) { return __hip_atomic_fetch_add(p, v, __ATOMIC_RELAXED, __HIP_MEMORY_SCOPE_AGENT); }
__device__ __forceinline__ unsigned xb_xcc_id() { return (unsigned)__builtin_amdgcn_s_getreg((3 << 11) | 20) & 0xFu; }
#define XB_SPIN(cond, bar) do { unsigned _sp = 0; while (cond) { __builtin_amdgcn_s_sleep(1); \
    if ((++_sp & 255u) == 0u) { if (xb_ld(&(bar)[XB_TMO])) break; if (_sp > XB_SPIN_CAP) { atomicAdd(&(bar)[XB_TMO], 1u); break; } } } } while (0)

static_assert(LRU_FLAG0 == XCD_BAR_WORDS, "LRU flags sit right behind the barrier words");
struct XcdBarrier {
    unsigned* bar; unsigned x;
    volatile LAS unsigned* st;
};

__device__ __forceinline__ XcdBarrier xcd_barrier_post(unsigned* bar, volatile LAS unsigned* st) {
    XcdBarrier b; b.bar = bar; b.x = xb_xcc_id(); b.st = st;
    if (threadIdx.x == 0) (void)xb_add(&bar[XB_XCNT(b.x)], 1u);
    return b;
}
__device__ __forceinline__ void xcd_barrier_complete(unsigned* bar, unsigned x, unsigned& nloc, unsigned& nx) {
    const unsigned G = gridDim.x * gridDim.y * gridDim.z;
    unsigned sum, cnt, mine, sp = 0u;
    for (;;) {
        sum = 0u; cnt = 0u; mine = 0u;
#pragma unroll
        for (unsigned j = 0; j < 16; ++j) { const unsigned c = xb_ld(&bar[XB_XCNT(j)]); sum += c; cnt += (c > 0u) ? 1u : 0u; mine = (j == x) ? c : mine; }
        if (sum == G) break;
        __builtin_amdgcn_s_sleep(1);
        if ((++sp & 255u) == 0u) { if (xb_ld(&bar[XB_TMO])) break; if (sp > XB_SPIN_CAP) { atomicAdd(&bar[XB_TMO], 1u); break; } }
    }
    nloc = mine > 0u ? mine : 1u; nx = cnt > 0u ? cnt : 1u;
}

__device__ __forceinline__ void xcd_barrier(const XcdBarrier& b) {
    asm volatile("s_waitcnt vmcnt(0)" ::: "memory");
    __syncthreads();
    if (threadIdx.x == 0) {
        unsigned* bar = b.bar;
        __builtin_amdgcn_s_waitcnt(0);
        unsigned nloc = b.st[0], nx = b.st[1];
        if (nloc == 0u) { xcd_barrier_complete(bar, b.x, nloc, nx); b.st[0] = nloc; b.st[1] = nx; }
        const unsigned old = xb_add(&bar[XB_XSUB(b.x)], 1u);
        const unsigned gen = old / nloc;
        if (old + 1u == (gen + 1u) * nloc) {
            __builtin_amdgcn_fence(__ATOMIC_RELEASE, "agent");
            asm volatile("s_waitcnt vmcnt(0)" ::: "memory");
            const unsigned og = xb_add(&bar[XB_TOP], 1u);
            const unsigned tg = og / nx;
            if (og + 1u == (tg + 1u) * nx) xb_add(&bar[XB_TOPGEN], 1u);
            else XB_SPIN(xb_ld(&bar[XB_TOPGEN]) == tg, bar);
            __builtin_amdgcn_fence(__ATOMIC_ACQUIRE, "agent");
            xb_add(&bar[XB_XGEN(b.x)], 1u);
            asm volatile("s_waitcnt vmcnt(0)" ::: "memory");
        } else {
            XB_SPIN(xb_ld(&bar[XB_XGEN(b.x)]) == gen, bar);
            __builtin_amdgcn_fence(__ATOMIC_ACQUIRE, "agent");
            asm volatile("s_waitcnt vmcnt(0)" ::: "memory");
        }
    }
    __syncthreads();
}


struct EpiOutF {
    static constexpr bool PERM = false, AFTER_DRAIN = true;
    const float* x; float* out; float* rowss; const float* fg; XcdBarrier xb; int G, c;
    template <bool KEEP>
    DI void add_residual(f32x4 (&acc)[2][2][4][2], const pg8::Unit& u, int wr, int wc, int fr, int fq) const {
        const int row0 = u.pm * 256 + wr * 64 + fr, col0 = u.pn * 256 + wc * 32 + 4 * fq;
#pragma unroll
        for (int ai = 0; ai < 2; ++ai) {
            f32x4 xv[4][2][2];
#pragma unroll
            for (int m = 0; m < 4; ++m)
#pragma unroll
                for (int bj = 0; bj < 2; ++bj)
#pragma unroll
                    for (int n = 0; n < 2; ++n)
                        xv[m][bj][n] = __builtin_nontemporal_load((const f32x4*)(x + (size_t)(row0 + ai * 128 + m * 16) * DM + col0 + bj * 128 + n * 16));
#pragma unroll
            for (int m = 0; m < 4; ++m) {
                const int row = row0 + ai * 128 + m * 16; float ss = 0.f;
#pragma unroll
                for (int bj = 0; bj < 2; ++bj)
#pragma unroll
                    for (int n = 0; n < 2; ++n) {
                        const f32x4 v = xv[m][bj][n] + acc[ai][bj][m][n];
                        if (KEEP) acc[ai][bj][m][n] = v; else *(f32x4*)(out + (size_t)row * DM + col0 + bj * 128 + n * 16) = v;
                        ss += v[0] * v[0] + v[1] * v[1] + v[2] * v[2] + v[3] * v[3];
                    }
                ss += __shfl_xor(ss, 16); ss += __shfl_xor(ss, 32);
                if (fq == 0) rowss[(size_t)row * 32 + u.pn * 4 + wc] = ss;
            }
        }
    }
    DI void operator()(const f32x4 (&acc)[2][2][4][2], const pg8::Unit& u, int wr, int wc, int fr, int fq) const {
        add_residual<false>(const_cast<f32x4 (&)[2][2][4][2]>(acc), u, wr, wc, fr, fq);
    }
    DI float row_rstd(int row) const {
        const f32x4* pr = (const f32x4*)(rowss + (size_t)row * 32); float ss = 0.f;
#pragma unroll
        for (int k = 0; k < 8; ++k) { const f32x4 v = pr[k]; ss += (v[0] + v[1]) + (v[2] + v[3]); }
        return rsqrtf(ss * (1.0f / DM) + 1e-6f);
    }
    DI void fused(f32x4 (&acc)[2][2][4][2], const pg8::Unit& u, int wr, int wc, int fr, int fq, PG8_LAS unsigned char* lds, int wid, int lane) const {
        const int row0 = u.pm * 256 + wr * 64 + fr, col0 = u.pn * 256 + wc * 32 + 4 * fq, tid = wid * 64 + lane;
        PG8_LAS float* rs = (PG8_LAS float*)lds;
        add_residual<true>(acc, u, wr, wc, fr, fq);
        f32x4 g4[2][2];
#pragma unroll
        for (int bj = 0; bj < 2; ++bj)
#pragma unroll
            for (int n = 0; n < 2; ++n) g4[bj][n] = *(const f32x4*)(fg + col0 + bj * 128 + n * 16);
        xcd_barrier(xb);
        if (tid < 256) rs[tid] = row_rstd(u.pm * 256 + tid);
        __syncthreads();
#pragma unroll
        for (int bj = 0; bj < 2; ++bj)
#pragma unroll
            for (int n = 0; n < 2; ++n) {
                const f32x4 g = g4[bj][n];
#pragma unroll
                for (int ai = 0; ai < 2; ++ai)
#pragma unroll
                    for (int m = 0; m < 4; ++m) {
                        const float r = rs[ai * 128 + wr * 64 + m * 16 + fr];
                        f32x4 v = acc[ai][bj][m][n];
                        v[0] *= r * g[0]; v[1] *= r * g[1]; v[2] *= r * g[2]; v[3] *= r * g[3];
                        *(f32x4*)(out + (size_t)(row0 + ai * 128 + m * 16) * DM + col0 + bj * 128 + n * 16) = v;
                    }
            }
        pg8::StaticOrder S; S.init(S_, DM, G, c);
        pg8::Unit u0, u1;
        for (int i = 0; S.next(i, u0) && S.next(i + 1, u1); ++i) {
            __syncthreads();
            if (tid < 256) rs[tid] = row_rstd(u0.pm * 256 + tid);
            __syncthreads();
            const f32x4 g = *(const f32x4*)(fg + u0.pn * 256 + lane * 4);
            f32x4 tv[32];
#pragma unroll
            for (int k = 0; k < 32; ++k) tv[k] = *(const f32x4*)(out + (size_t)(u0.pm * 256 + k * 8 + wid) * DM + u0.pn * 256 + lane * 4);
#pragma unroll
            for (int k = 0; k < 32; ++k) {
                const int row = k * 8 + wid; const float r = rs[row];
                f32x4 v = tv[k]; v[0] *= r * g[0]; v[1] *= r * g[1]; v[2] *= r * g[2]; v[3] *= r * g[3];
                *(f32x4*)(out + (size_t)(u0.pm * 256 + row) * DM + u0.pn * 256 + lane * 4) = v;
            }
        }
    }
};

#ifndef N_LAUNCHES
#define N_LAUNCHES 1
#endif
__global__ void __launch_bounds__(NTHR, 2) mega_fwd(Params p) {
    extern __shared__ __attribute__((aligned(16))) unsigned char smem[];
    cg::grid_group grid = cg::this_grid();
    __shared__ uint4 xb_words;
    if (threadIdx.x == 0) xb_words = make_uint4(0u, 0u, 0u, 0u);
    __syncthreads();
    if (p.ph_hi > 1000) grid.sync();
    XcdBarrier xbar = xcd_barrier_post((unsigned*)(p.ws + WS_BAR), (volatile LAS unsigned*)&xb_words);
#define IN(k) (p.ph_lo <= (k) && (k) < p.ph_hi)
#define SEAM(k) do { if (IN(k) && IN((k) + 1)) xcd_barrier(xbar); } while (0)
#ifndef PROBE_PH
#define PROBE_PH -1
#endif
#define REPS(k) ((PROBE_PH == (k)) ? 2 : 1)
    for (int rep = 0; rep < REPS(0); ++rep) { if (IN(0)) p0_prep(p, smem); SEAM(0); }
    {
        if (IN(1)) {
            pg8::Gemm g{(const u16*)p.out, (const u16*)((const unsigned char*)p.out + 64 * MiB), S_, NIN, DM};
            pg8::StaticOrder S; S.init(S_, NIN, (int)gridDim.x, (int)blockIdx.x); S.rep = REPS(1);
            EpiProj E{(u16*)(p.ws + WS_LX), (u16*)(p.ws + WS_Q), (u16*)(p.ws + WS_K), (u16*)(p.ws + WS_V), (u16*)(p.ws + WS_G), p.b_merge};
            pg8::gemm_phase<EpiProj, pg8::StaticOrder, false>((PG8_LAS unsigned char*)smem, g, S, E, nullptr);
        }
        SEAM(1);
    }
    if (IN(2)) {
#pragma unroll 1
        for (int half = 0; half < 2; ++half) {
            if ((half == 0) == ((blockIdx.x >> 3) & 1)) {
                for (int it = blockIdx.x; it < 512; it += gridDim.x) attn_unit(p, smem, it & 15, it >> 4, (u16*)(p.ws + WS_G));
            } else {
                for (int u = blockIdx.x; u < 256; u += gridDim.x) lru_unit<false>(p, smem, u >> 4, u & 15, nullptr);
            }
        }
    }
    if (IN(3)) {
#pragma unroll 1
        for (int half = 0; half < 2; ++half) {
            if ((half == 0) == ((blockIdx.x >> 3) & 1)) {
                for (int it = 512 + blockIdx.x; it < 1024; it += gridDim.x) attn_unit(p, smem, it & 15, it >> 4, (u16*)(p.ws + WS_G));
            } else {
                for (int u = blockIdx.x; u < 256; u += gridDim.x) lru_unit<true>(p, smem, u >> 4, u & 15, (u16*)(p.ws + WS_G));
            }
        }
    }
    SEAM(3);
    if (IN(4)) {
        pg8::Gemm g{(const u16*)(p.ws + WS_G), (const u16*)(p.ws + WS_WOUT), S_, DM, DCAT};
        pg8::StaticOrder S; S.init(S_, DM, (int)gridDim.x, (int)blockIdx.x);
        EpiOutF E{p.x, p.out, (float*)(p.ws + WS_ROWSS), p.final_g, xbar, (int)gridDim.x, (int)blockIdx.x};
        pg8::gemm_phase<EpiOutF, pg8::StaticOrder, false>((PG8_LAS unsigned char*)smem, g, S, E, nullptr);
    }
#undef IN
#undef SEAM
}

extern "C" void kernel_launch(void* const* d_in, const int* in_sizes, int n_in, void* d_out, int out_size, void* d_ws, size_t ws_size, hipStream_t stream) {
    static int grid = 0;
    if (grid == 0) {
        int dev = 0, cus = 0, per_cu = 0;
        hipGetDevice(&dev);
        hipDeviceGetAttribute(&cus, hipDeviceAttributeMultiprocessorCount, dev);
        if (hipFuncSetAttribute((const void*)mega_fwd, hipFuncAttributeMaxDynamicSharedMemorySize, LDS_BYTES) != hipSuccess) fprintf(stderr, "kernel_launch: hipFuncSetAttribute failed\n");
        if (hipOccupancyMaxActiveBlocksPerMultiprocessor(&per_cu, (const void*)mega_fwd, NTHR, LDS_BYTES) != hipSuccess || per_cu < 1) { fprintf(stderr, "kernel_launch: occupancy query gave %d\n", per_cu); per_cu = 1; }
        (void)hipGetLastError();
        if (per_cu > 1) per_cu = 1;
        grid = cus * per_cu;
        if (ws_size < WS_END) fprintf(stderr, "kernel_launch: workspace too small: %zu < %zu\n", ws_size, (size_t)WS_END);
    }
    Params p{};
    p.x = (const float*)d_in[0]; p.norm_g = (const float*)d_in[1]; p.w_in = (const float*)d_in[2]; p.conv_w = (const float*)d_in[3]; p.conv_b = (const float*)d_in[4];
    p.w_rg = (const float*)d_in[5]; p.b_rg = (const float*)d_in[6]; p.w_ig = (const float*)d_in[7]; p.b_ig = (const float*)d_in[8]; p.lam = (const float*)d_in[9];
    p.b_merge = (const float*)d_in[10]; p.w_out = (const float*)d_in[11]; p.final_g = (const float*)d_in[12];
    p.out = (float*)d_out; p.ws = (unsigned char*)d_ws;
#if N_LAUNCHES == 1
    p.ph_lo = 0; p.ph_hi = 6;
    if (hipMemsetAsync((unsigned char*)d_ws + WS_BAR, 0, (XCD_BAR_WORDS + 256) * sizeof(unsigned), stream) != hipSuccess) fprintf(stderr, "kernel_launch: memset of the barrier words failed\n");
    void* args[] = {&p};
    hipError_t e = hipLaunchCooperativeKernel((const void*)mega_fwd, dim3(grid), dim3(NTHR), args, LDS_BYTES, stream);
    if (e != hipSuccess) fprintf(stderr, "cooperative launch failed: %s (grid %d)\n", hipGetErrorString(e), grid);
#else
    for (int ph = 0; ph < 6; ++ph) {
        p.ph_lo = ph; p.ph_hi = ph + 1;
        hipLaunchKernelGGL(mega_fwd, dim3(grid), dim3(NTHR), LDS_BYTES, stream, p);
    }
#endif
}
```
